# Optimizing an MI355X kernel written in HIP

```python
import math
import jax
import jax.numpy as jnp
from jax import lax
import numpy as np

D_MODEL = 1024
BATCH = 4
SEQ = 8192
DEPTH = 2

HEAD_DIM = 64
Q_BLOCK = 128
N_BRANCH = 4
BRANCH_WIDTH = 256

MOBA_HEADS = 4
MOBA_BLOCK = 256
MOBA_TOPK = 3

DIFF_HEADS = 4
DIFF_QK_DIM = 32
DIFF_V_DIM = 2 * DIFF_QK_DIM

SB_HEADS = 4

SWA_Q_HEADS = 4
SWA_KV_HEADS = 2
SWA_WINDOW = 128

REL_BUCKETS = 32
REL_MAX_DIST = 128
N_BIAS_HEADS = MOBA_HEADS + DIFF_HEADS + SWA_Q_HEADS

N_GROUPS = 4
EXPERTS_PER_GROUP = 8
N_EXPERTS = N_GROUPS * EXPERTS_PER_GROUP
EXPERT_TOPK = 2
D_EXPERT = 512
MOE_BLOCK = 128

NORM_EPS = 1e-6

MOBA_COLS = 3 * MOBA_HEADS * HEAD_DIM
DIFF_COLS = DIFF_HEADS * (4 * DIFF_QK_DIM + DIFF_V_DIM)
SB_COLS = 3 * SB_HEADS * HEAD_DIM
SWA_COLS = (SWA_Q_HEADS + 2 * SWA_KV_HEADS) * HEAD_DIM
IN_COLS = MOBA_COLS + DIFF_COLS + SB_COLS + SWA_COLS

kernel_name = "hybrid_gated_moba_diff_stickbreak_swa_hmoe"


def rmsnorm(x, g):
    x32 = x.astype(jnp.float32)
    y = x32 * lax.rsqrt(jnp.mean(x32 * x32, axis=-1, keepdims=True) + NORM_EPS)
    return (y * g.astype(jnp.float32)).astype(x.dtype)


def rel_bucket(dist):
    n = jnp.maximum(dist, 0)
    max_exact = REL_BUCKETS // 2
    nf = jnp.maximum(n, 1).astype(jnp.float32)
    large = max_exact + (jnp.log(nf / max_exact) / math.log(REL_MAX_DIST / max_exact)
                         * (REL_BUCKETS - max_exact)).astype(jnp.int32)
    large = jnp.minimum(large, REL_BUCKETS - 1)
    return jnp.where(n < max_exact, n, large)


def head_bias(tab, dist):
    return jnp.take(tab, rel_bucket(dist), axis=1).astype(jnp.float32)


def moba_attention(q, k, v, tab):
    B, S, H, d = q.shape
    nb = -(-S // MOBA_BLOCK)
    pad = nb * MOBA_BLOCK - S
    q = q.transpose(0, 2, 1, 3)
    k = jnp.pad(k.transpose(0, 2, 1, 3), ((0, 0), (0, 0), (0, pad), (0, 0)))
    v = jnp.pad(v.transpose(0, 2, 1, 3), ((0, 0), (0, 0), (0, pad), (0, 0)))
    kblk = k.reshape(B, H, nb, MOBA_BLOCK, d)
    vblk = v.reshape(B, H, nb, MOBA_BLOCK, d)
    kmean = jnp.mean(kblk.astype(jnp.float32), axis=3).astype(k.dtype)
    topk = min(MOBA_TOPK, nb)
    scale = d ** -0.5
    bi = jnp.arange(B)[:, None, None, None]
    hi = jnp.arange(H)[None, :, None, None]
    in_blk = jnp.arange(MOBA_BLOCK)

    def chunk(c):
        t0 = c * Q_BLOCK
        qc = lax.dynamic_slice_in_dim(q, t0, Q_BLOCK, axis=2)
        tpos = t0 + jnp.arange(Q_BLOCK)
        own = t0 // MOBA_BLOCK
        gate = jnp.einsum('bhqd,bhnd->bhqn', qc, kmean).astype(jnp.float32)
        gate = jnp.where(jnp.arange(nb) < own, gate, -jnp.inf)
        gval, gidx = lax.top_k(gate, topk)
        ks = kblk[bi, hi, gidx]
        vs = vblk[bi, hi, gidx]
        s_sel = jnp.einsum('bhqd,bhqjkd->bhqjk', qc, ks).astype(jnp.float32) * scale
        kpos = gidx[..., None] * MOBA_BLOCK + in_blk
        s_sel = s_sel + tab[hi[..., None], rel_bucket(tpos[:, None, None] - kpos)].astype(jnp.float32)
        s_sel = jnp.where(jnp.isfinite(gval)[..., None], s_sel, -jnp.inf)
        ko = lax.dynamic_slice_in_dim(k, own * MOBA_BLOCK, MOBA_BLOCK, axis=2)
        vo = lax.dynamic_slice_in_dim(v, own * MOBA_BLOCK, MOBA_BLOCK, axis=2)
        dist = tpos[:, None] - (own * MOBA_BLOCK + in_blk)[None, :]
        s_own = jnp.einsum('bhqd,bhkd->bhqk', qc, ko).astype(jnp.float32) * scale + head_bias(tab, dist)[None]
        s_own = jnp.where(dist >= 0, s_own, -jnp.inf)
        logits = jnp.concatenate([s_sel.reshape(B, H, Q_BLOCK, topk * MOBA_BLOCK), s_own], axis=-1)
        p = jax.nn.softmax(logits, axis=-1).astype(v.dtype)
        p_sel = p[..., :topk * MOBA_BLOCK].reshape(B, H, Q_BLOCK, topk, MOBA_BLOCK)
        p_own = p[..., topk * MOBA_BLOCK:]
        return (jnp.einsum('bhqjk,bhqjkd->bhqd', p_sel, vs)
                + jnp.einsum('bhqk,bhkd->bhqd', p_own, vo))

    out = lax.map(chunk, jnp.arange(S // Q_BLOCK))
    return out.transpose(1, 0, 3, 2, 4).reshape(B, S, H * d)


def diff_attention(q1, q2, k1, k2, v, lam, lam_init, subln_g, tab):
    B, S, H, dq = q1.shape
    dv = v.shape[-1]
    scale = dq ** -0.5
    kpos = jnp.arange(S)

    def chunk(c):
        t0 = c * Q_BLOCK
        dist = (t0 + jnp.arange(Q_BLOCK))[:, None] - kpos[None, :]
        causal = dist >= 0
        bias = head_bias(tab, dist)

        def probs(qa, ka):
            qc = lax.dynamic_slice_in_dim(qa, t0, Q_BLOCK, axis=1)
            s = jnp.einsum('bqhd,bkhd->bhqk', qc, ka).astype(jnp.float32) * scale + bias
            return jax.nn.softmax(jnp.where(causal, s, -jnp.inf), axis=-1)

        a = probs(q1, k1) - lam * probs(q2, k2)
        return jnp.einsum('bhqk,bkhd->bqhd', a.astype(v.dtype), v)

    out = lax.map(chunk, jnp.arange(S // Q_BLOCK))
    out = out.transpose(1, 0, 2, 3, 4).reshape(B, S, H, dv)
    out = rmsnorm(out, subln_g) * (1.0 - lam_init)
    return out.reshape(B, S, H * dv)


def stick_breaking_attention(q, k, v):
    B, S, H, d = q.shape
    scale = d ** -0.5
    kpos = jnp.arange(S)

    def chunk(c):
        t0 = c * Q_BLOCK
        qc = lax.dynamic_slice_in_dim(q, t0, Q_BLOCK, axis=1)
        strict = (t0 + jnp.arange(Q_BLOCK))[:, None] > kpos[None, :]
        z = jnp.einsum('bqhd,bkhd->bhqk', qc, k).astype(jnp.float32) * scale
        log_keep = jnp.where(strict, jax.nn.log_sigmoid(-z), 0.0)
        later = lax.cumsum(log_keep, axis=3, reverse=True) - log_keep
        w = jnp.where(strict, jnp.exp(jax.nn.log_sigmoid(z) + later), 0.0)
        return jnp.einsum('bhqk,bkhd->bqhd', w.astype(v.dtype), v)

    out = lax.map(chunk, jnp.arange(S // Q_BLOCK))
    return out.transpose(1, 0, 2, 3, 4).reshape(B, S, H * d)


def sliding_window_attention(q, k, v, sinks, tab):
    B, S, Hq, d = q.shape
    Hkv = k.shape[2]
    G = Hq // Hkv
    nb = S // Q_BLOCK
    qb = q.reshape(B, nb, Q_BLOCK, Hkv, G, d)

    def band(t):
        tb = t.reshape(B, nb, Q_BLOCK, Hkv, d)
        prev = jnp.pad(tb[:, :-1], ((0, 0), (1, 0), (0, 0), (0, 0), (0, 0)))
        return jnp.concatenate([prev, tb], axis=2)

    kb, vb = band(k), band(v)
    s = jnp.einsum('bnqkgd,bnskd->bnkgqs', qb, kb).astype(jnp.float32) * d ** -0.5
    qi = jnp.arange(Q_BLOCK)[:, None]
    sj = jnp.arange(2 * Q_BLOCK)[None, :]
    dist = qi + Q_BLOCK - sj
    in_win = (dist >= 0) & (dist < SWA_WINDOW)
    key_abs = jnp.arange(nb)[:, None, None] * Q_BLOCK + sj[None] - Q_BLOCK
    valid = in_win[None] & (key_abs >= 0)
    s = s + head_bias(tab, dist).reshape(Hkv, G, Q_BLOCK, 2 * Q_BLOCK)[None, None]
    s = jnp.where(valid[None, :, None, None], s, -jnp.inf)
    sink = sinks.astype(jnp.float32).reshape(1, 1, Hkv, G, 1, 1)
    m = jnp.maximum(jnp.max(s, axis=-1, keepdims=True), sink)
    e = jnp.exp(s - m)
    p = e / (jnp.sum(e, axis=-1, keepdims=True) + jnp.exp(sink - m))
    o = jnp.einsum('bnkgqs,bnskd->bnqkgd', p.astype(v.dtype), vb)
    return o.reshape(B, S, Hq * d)


def hierarchical_moe(h, w_rg, b_rg, w_re, b_re, w1, w3, w2):
    B, S, D = h.shape
    xf = h.reshape(-1, D)
    N = xf.shape[0]
    g_logits = (xf @ w_rg).astype(jnp.float32) + b_rg.astype(jnp.float32)
    g_prob = jax.nn.softmax(g_logits, axis=-1)
    grp = jnp.argmax(g_logits, axis=-1)
    p_grp = jnp.take_along_axis(g_prob, grp[:, None], axis=1)
    e_logits = ((xf @ w_re).astype(jnp.float32) + b_re.astype(jnp.float32)).reshape(N, N_GROUPS, EXPERTS_PER_GROUP)
    e_logits = jnp.take_along_axis(e_logits, grp[:, None, None], axis=1)[:, 0]
    top_val, top_idx = lax.top_k(e_logits, EXPERT_TOPK)
    gate = p_grp * jax.nn.softmax(top_val, axis=-1)
    expert = grp[:, None] * EXPERTS_PER_GROUP + top_idx

    A = N * EXPERT_TOPK
    eid = expert.reshape(-1)
    order = jnp.argsort(eid)
    eid_s = eid[order]
    tok_s = order // EXPERT_TOPK
    gate_s = gate.reshape(-1)[order]
    counts = jnp.bincount(eid, length=N_EXPERTS)
    padded = (counts + MOE_BLOCK - 1) // MOE_BLOCK * MOE_BLOCK
    pad_end = jnp.cumsum(padded)
    pad_start = pad_end - padded
    start = jnp.cumsum(counts) - counts
    dest = pad_start[eid_s] + jnp.arange(A) - start[eid_s]
    R = ((A + MOE_BLOCK - 1) // MOE_BLOCK + N_EXPERTS) * MOE_BLOCK
    nblk = R // MOE_BLOCK
    xbuf = jnp.zeros((R, D), xf.dtype).at[dest].set(xf[tok_s])
    blk_expert = jnp.minimum(jnp.searchsorted(pad_end, jnp.arange(nblk) * MOE_BLOCK, side='right'), N_EXPERTS - 1)

    def expert_block(args):
        xb, e = args
        return (jax.nn.silu(xb @ w1[e]) * (xb @ w3[e])) @ w2[e]

    ybuf = lax.map(expert_block, (xbuf.reshape(nblk, MOE_BLOCK, D), blk_expert)).reshape(R, D)
    y = ybuf[dest] * gate_s[:, None].astype(ybuf.dtype)
    out = jnp.zeros((N, D), h.dtype).at[tok_s].add(y)
    return out.reshape(B, S, D)


def setup_inputs(seed: int = 0) -> dict:
    key = jax.random.key(seed)
    ks = jax.random.split(key, 24)

    def nrm(k, shape, scale):
        return jax.random.normal(k, shape, jnp.float32) * scale

    return {
        "x": nrm(ks[0], (BATCH, SEQ, D_MODEL), 1.0),
        "rel_bias": nrm(ks[1], (REL_BUCKETS, N_BIAS_HEADS), 0.5),
        "g_mix": 1.0 + nrm(ks[2], (DEPTH, D_MODEL), 0.02),
        "w_in": nrm(ks[3], (DEPTH, D_MODEL, IN_COLS), D_MODEL ** -0.5),
        "diff_lq1": nrm(ks[4], (DEPTH, DIFF_QK_DIM), 0.1),
        "diff_lk1": nrm(ks[5], (DEPTH, DIFF_QK_DIM), 0.1),
        "diff_lq2": nrm(ks[6], (DEPTH, DIFF_QK_DIM), 0.1),
        "diff_lk2": nrm(ks[7], (DEPTH, DIFF_QK_DIM), 0.1),
        "diff_subln": 1.0 + nrm(ks[8], (DEPTH, DIFF_V_DIM), 0.02),
        "swa_sinks": nrm(ks[9], (DEPTH, SWA_Q_HEADS), 1.0),
        "w_gate": nrm(ks[10], (DEPTH, N_BRANCH, D_MODEL, D_MODEL), D_MODEL ** -0.5),
        "w_br": nrm(ks[11], (DEPTH, N_BRANCH, BRANCH_WIDTH, D_MODEL), BRANCH_WIDTH ** -0.5),
        "w_o": nrm(ks[12], (DEPTH, D_MODEL, D_MODEL), D_MODEL ** -0.5),
        "g_ffn": 1.0 + nrm(ks[13], (DEPTH, D_MODEL), 0.02),
        "w_route_group": nrm(ks[14], (DEPTH, D_MODEL, N_GROUPS), D_MODEL ** -0.5),
        "b_route_group": nrm(ks[15], (DEPTH, N_GROUPS), 0.01),
        "w_route_expert": nrm(ks[16], (DEPTH, D_MODEL, N_EXPERTS), D_MODEL ** -0.5),
        "b_route_expert": nrm(ks[17], (DEPTH, N_EXPERTS), 0.01),
        "w1": nrm(ks[18], (DEPTH, N_EXPERTS, D_MODEL, D_EXPERT), D_MODEL ** -0.5),
        "w3": nrm(ks[19], (DEPTH, N_EXPERTS, D_MODEL, D_EXPERT), D_MODEL ** -0.5),
        "w2": nrm(ks[20], (DEPTH, N_EXPERTS, D_EXPERT, D_MODEL), D_EXPERT ** -0.5),
        "g_final": 1.0 + nrm(ks[21], (D_MODEL,), 0.02),
    }


def reference(x, rel_bias, g_mix, w_in, diff_lq1, diff_lk1, diff_lq2, diff_lk2, diff_subln,
              swa_sinks, w_gate, w_br, w_o, g_ffn, w_route_group, b_route_group,
              w_route_expert, b_route_expert, w1, w3, w2, g_final):
    B, S, _ = x.shape
    tab = rel_bias.T
    tab_moba = tab[:MOBA_HEADS]
    tab_diff = tab[MOBA_HEADS:MOBA_HEADS + DIFF_HEADS]
    tab_swa = tab[MOBA_HEADS + DIFF_HEADS:]
    dq = DIFF_HEADS * DIFF_QK_DIM
    for l in range(DEPTH):
        h = rmsnorm(x, g_mix[l])
        proj = h @ w_in[l]
        pa, pb, pc, pd = jnp.split(proj, [MOBA_COLS, MOBA_COLS + DIFF_COLS,
                                          MOBA_COLS + DIFF_COLS + SB_COLS], axis=-1)
        qa, ka, va = [t.reshape(B, S, MOBA_HEADS, HEAD_DIM) for t in jnp.split(pa, 3, axis=-1)]
        o_a = moba_attention(qa, ka, va, tab_moba)
        q1, q2, k1, k2, vb = jnp.split(pb, [dq, 2 * dq, 3 * dq, 4 * dq], axis=-1)
        q1, q2, k1, k2 = [t.reshape(B, S, DIFF_HEADS, DIFF_QK_DIM) for t in (q1, q2, k1, k2)]
        vb = vb.reshape(B, S, DIFF_HEADS, DIFF_V_DIM)
        lam_init = 0.8 - 0.6 * math.exp(-0.3 * l)
        lam = (jnp.exp(jnp.sum(diff_lq1[l].astype(jnp.float32) * diff_lk1[l].astype(jnp.float32)))
               - jnp.exp(jnp.sum(diff_lq2[l].astype(jnp.float32) * diff_lk2[l].astype(jnp.float32)))
               + lam_init)
        o_b = diff_attention(q1, q2, k1, k2, vb, lam, lam_init, diff_subln[l], tab_diff)
        qc, kc, vc = [t.reshape(B, S, SB_HEADS, HEAD_DIM) for t in jnp.split(pc, 3, axis=-1)]
        o_c = stick_breaking_attention(qc, kc, vc)
        qd, kd, vd = jnp.split(pd, [SWA_Q_HEADS * HEAD_DIM, (SWA_Q_HEADS + SWA_KV_HEADS) * HEAD_DIM], axis=-1)
        o_d = sliding_window_attention(qd.reshape(B, S, SWA_Q_HEADS, HEAD_DIM),
                                       kd.reshape(B, S, SWA_KV_HEADS, HEAD_DIM),
                                       vd.reshape(B, S, SWA_KV_HEADS, HEAD_DIM),
                                       swa_sinks[l], tab_swa)
        branches = (o_a, o_b, o_c, o_d)
        merged = jax.nn.sigmoid(h @ w_gate[l, 0]) * (branches[0] @ w_br[l, 0])
        for i in range(1, N_BRANCH):
            merged = merged + jax.nn.sigmoid(h @ w_gate[l, i]) * (branches[i] @ w_br[l, i])
        x = x + merged @ w_o[l]
        x = x + hierarchical_moe(rmsnorm(x, g_ffn[l]), w_route_group[l], b_route_group[l],
                                 w_route_expert[l], b_route_expert[l], w1[l], w3[l], w2[l])
    return rmsnorm(x, g_final)
```

```cpp
#include <hip/hip_runtime.h>
#include <cstdio>
#include <cstdint>

#ifndef MK_N_LAUNCHES
#define MK_N_LAUNCHES 1
#endif

#define GAS __attribute__((address_space(1)))
#define LAS __attribute__((address_space(3)))
typedef unsigned short bf16_t;
typedef short bf16x8 __attribute__((ext_vector_type(8)));
typedef short s16x4 __attribute__((ext_vector_type(4)));
typedef float f32x4 __attribute__((ext_vector_type(4)));
typedef float f32x16 __attribute__((ext_vector_type(16)));
typedef unsigned u32x4 __attribute__((ext_vector_type(4)));
typedef unsigned u32x2 __attribute__((ext_vector_type(2)));
typedef float f32x2_t __attribute__((ext_vector_type(2)));
typedef __bf16 bf16x2_t __attribute__((ext_vector_type(2)));
typedef LAS unsigned char* ldsp;

constexpr int DM = 1024, NB = 4, SEQ = 8192, NTOK = NB * SEQ, DEPTH = 2;
constexpr int INC = 2816;
constexpr int NEXP = 32, DEXP = 512;
constexpr int MOE_ROWS = 2 * NTOK + NEXP * 256;
constexpr float NORM_EPS = 1e-6f;
constexpr float LOG2E = 1.4426950408889634f;
constexpr int CA_Q = 0, CA_K = 256, CA_V = 512;
constexpr int CB_Q1 = 768, CB_Q2 = 896, CB_K1 = 1024, CB_K2 = 1152, CB_V = 1280;
constexpr int CC_Q = 1536, CC_K = 1792, CC_V = 2048;
constexpr int CD_Q = 2304, CD_K = 2560, CD_V = 2688;

constexpr size_t MiB = 1u << 20;
constexpr size_t WS_CTL = 0, CTL_ZERO_BYTES = 1024 * 1024;
constexpr size_t WS_WIN = 1 * MiB, WS_WG = 7 * MiB, WS_WBR = 15 * MiB, WS_WO = 17 * MiB, WS_W13 = 19 * MiB, WS_W2 = 83 * MiB;
constexpr size_t WS_R = 115 * MiB;
constexpr size_t WS_H = 355 * MiB;
constexpr size_t WS_PROJ = 179 * MiB;
constexpr size_t WS_O = 355 * MiB;
constexpr size_t WS_MERGED = 419 * MiB;
constexpr size_t WS_H2 = 387 * MiB;
constexpr size_t WS_ELIST = 487 * MiB;
constexpr size_t WS_Y8 = 251 * MiB;
constexpr size_t WS_HID = 323 * MiB;
constexpr size_t WS_S = 483 * MiB;
constexpr size_t WS_TOK = 515 * MiB;
constexpr size_t WS_H8 = 516 * MiB;
constexpr size_t WS_END = 548 * MiB;
static_assert(WS_Y8 + (size_t)MOE_ROWS * 1024 <= WS_HID && WS_HID + (size_t)MOE_ROWS * 512 <= WS_H2 && WS_H2 + (size_t)NTOK * 1024 <= WS_MERGED, "moe overlay");
constexpr int CW_BAR = 4096;
constexpr int CW_Q = 8192;
constexpr int CW_CNT = 12288;
constexpr int CW_LAM = 20480;
constexpr int CW_KDONE = 20480 + 64;
constexpr size_t CTL_KMEAN = 256 * 1024;
constexpr size_t CTL_MCNT = 512 * 1024;
constexpr size_t WS_MPO = 419 * MiB;
constexpr size_t WS_MML = 483 * MiB;
constexpr size_t WS_MLIST = 487 * MiB;

constexpr int LDS_BYTES = 160 * 1024;
constexpr int LDS_XB = LDS_BYTES - 16;

#define LDS_WAIT() asm volatile("s_waitcnt lgkmcnt(0)" ::: "memory")
#define VM_WAIT() asm volatile("s_waitcnt vmcnt(0)" ::: "memory")
__device__ __forceinline__ unsigned cvtpk(float lo, float hi) { f32x2_t v = {lo, hi}; bf16x2_t b = __builtin_convertvector(v, bf16x2_t); return __builtin_bit_cast(unsigned, b); }
__device__ __forceinline__ unsigned pk_fp8x4(float a, float b, float c, float d) { int w = 0; w = __builtin_amdgcn_cvt_pk_fp8_f32(a, b, w, false); w = __builtin_amdgcn_cvt_pk_fp8_f32(c, d, w, true); return (unsigned)w; }
__device__ __forceinline__ float bf_lo(unsigned w) { return __uint_as_float(w << 16); }
__device__ __forceinline__ float bf_hi(unsigned w) { return __uint_as_float(w & 0xffff0000u); }
__device__ __forceinline__ float shflx(float v, int mask, int lane) { return __int_as_float(__builtin_amdgcn_ds_bpermute((lane ^ mask) << 2, __float_as_int(v))); }
__device__ __forceinline__ int shflxi(int v, int mask, int lane) { return __builtin_amdgcn_ds_bpermute((lane ^ mask) << 2, v); }
template <int CTRL> __device__ __forceinline__ float dpp_mov(float v) { return __int_as_float(__builtin_amdgcn_update_dpp(0, __float_as_int(v), CTRL, 0xf, 0xf, true)); }
__device__ __forceinline__ float wave_sum(float v, int lane) {
    (void)lane;
    v += dpp_mov<0xB1>(v); v += dpp_mov<0x4E>(v); v += dpp_mov<0x141>(v); v += dpp_mov<0x140>(v);
    { auto rr = __builtin_amdgcn_permlane16_swap(__float_as_uint(v), __float_as_uint(v), false, false); v = __uint_as_float(rr[0]) + __uint_as_float(rr[1]); }
    { auto rr = __builtin_amdgcn_permlane32_swap(__float_as_uint(v), __float_as_uint(v), false, false); v = __uint_as_float(rr[0]) + __uint_as_float(rr[1]); }
    return v;
}

#define XB_TMO      128
#define XB_XCNT(j)  (256  + 64 * (j))
#define XB_XSUB(j)  (1280 + 64 * (j))
#define XB_XGEN(j)  (2304 + 64 * (j))
#define XB_TOP      3328
#define XB_TOPGEN   3392
#define XCD_BAR_WORDS 3456
#define XB_SPIN_CAP (1u << 18)
__device__ __forceinline__ unsigned xb_ld(unsigned* p)              { return __hip_atomic_load(p, __ATOMIC_RELAXED, __HIP_MEMORY_SCOPE_AGENT); }
__device__ __forceinline__ unsigned xb_add(unsigned* p, unsigned v) { return __hip_atomic_fetch_add(p, v, __ATOMIC_RELAXED, __HIP_MEMORY_SCOPE_AGENT); }
__device__ __forceinline__ unsigned xb_xcc_id() { return (unsigned)__builtin_amdgcn_s_getreg((3 << 11) | 20) & 0xFu; }
#define XB_SPIN(cond, bar) do { unsigned _sp = 0; while (cond) { __builtin_amdgcn_s_sleep(1); \
    if ((++_sp & 255u) == 0u) { if (xb_ld(&(bar)[XB_TMO])) break; if (_sp > XB_SPIN_CAP) { atomicAdd(&(bar)[XB_TMO], 1u); break; } } } } while (0)
struct XcdBarrier { unsigned* bar; unsigned x; volatile LAS unsigned* st; };
__device__ __forceinline__ XcdBarrier xcd_barrier_post(unsigned* bar, volatile LAS unsigned* st, const bool leader) {
    XcdBarrier b; b.bar = bar; b.x = xb_xcc_id(); b.st = st;
    if (leader) (void)xb_add(&bar[XB_XCNT(b.x)], 1u);
    return b;
}
__device__ __forceinline__ void xcd_barrier_complete(unsigned* bar, unsigned x, unsigned& nloc, unsigned& nx) {
    const unsigned G = gridDim.x * gridDim.y * gridDim.z;
    unsigned sum, cnt, mine, sp = 0u;
    for (;;) {
        sum = 0u; cnt = 0u; mine = 0u;
#pragma unroll 1
        for (unsigned j = 0; j < 16; ++j) { const unsigned c = xb_ld(&bar[XB_XCNT(j)]); sum += c; cnt += (c > 0u) ? 1u : 0u; mine = (j == x) ? c : mine; }
        if (sum == G) break;
        __builtin_amdgcn_s_sleep(1);
        if ((++sp & 255u) == 0u) { if (xb_ld(&bar[XB_TMO])) break; if (sp > XB_SPIN_CAP) { atomicAdd(&bar[XB_TMO], 1u); break; } }
    }
    nloc = mine > 0u ? mine : 1u; nx = cnt > 0u ? cnt : 1u;
}
__device__ __forceinline__ void xcd_barrier(const XcdBarrier& b, const bool leader  ) {
    asm volatile("s_waitcnt vmcnt(0)" ::: "memory");
    __syncthreads();
    if (leader) {
        unsigned* bar = b.bar;
        __builtin_amdgcn_s_waitcnt(0);
        unsigned nloc = b.st[0], nx = b.st[1];
        if (nloc == 0u) { xcd_barrier_complete(bar, b.x, nloc, nx); b.st[0] = nloc; b.st[1] = nx; }
        const unsigned old = xb_add(&bar[XB_XSUB(b.x)], 1u);
        const unsigned gen = old / nloc;
        if (old + 1u == (gen + 1u) * nloc) {
            __builtin_amdgcn_fence(__ATOMIC_RELEASE, "agent");
            asm volatile("s_waitcnt vmcnt(0)" ::: "memory");
            const unsigned og = xb_add(&bar[XB_TOP], 1u);
            const unsigned tg = og / nx;
            if (og + 1u == (tg + 1u) * nx) xb_add(&bar[XB_TOPGEN], 1u);
            else XB_SPIN(xb_ld(&bar[XB_TOPGEN]) == tg, bar);
            __builtin_amdgcn_fence(__ATOMIC_ACQUIRE, "agent");
            xb_add(&bar[XB_XGEN(b.x)], 1u);
            asm volatile("s_waitcnt vmcnt(0)" ::: "memory");
        } else {
            XB_SPIN(xb_ld(&bar[XB_XGEN(b.x)]) == gen, bar);
            __builtin_amdgcn_fence(__ATOMIC_ACQUIRE, "agent");
            asm volatile("s_waitcnt vmcnt(0)" ::: "memory");
        }
    }
    __syncthreads();
}

struct Args { const float* in[22]; float* out; unsigned char* ws; int ph_lo, ph_hi; };
typedef const float* __attribute__((address_space(4))) const* karg_in_t;
struct Frame {
    ldsp lds; unsigned* ctl; unsigned char* ws; karg_in_t in; float* out;
    int tid, lane, wave, G, bid;
};

namespace pg8 {
constexpr int BM = 256, BK = 64, HALF = 128, HTB = HALF * BK * 2, STAGE_BYTES = 8 * HTB, NXCD = 8, WGM = 8;
__device__ __forceinline__ int lds_byte(int r, int c) { const int st = (r >> 4) * 2 + (c >> 5), rr = r & 15, cc = c & 31, ob = rr * 64 + cc * 2; return st * 1024 + (ob ^ (((ob >> 9) & 1) << 5)); }
__device__ __forceinline__ void stage_rc(int b, int& R, int& C) { const int st = b / 1024, sb = b % 1024, swz = sb ^ (((sb >> 9) & 1) << 5); R = (st >> 1) * 16 + swz / 64; C = (st & 1) * 32 + (swz % 64) / 2; }
__device__ __forceinline__ int perm32(int rho) { const int n = rho >> 4, i = rho & 15; return 8 * (i >> 2) + 4 * n + (i & 3); }

struct GU { const char* A; const char* B; unsigned pa, pb; int nt; int pm, pn, aux; int f8; const unsigned* rows; int nrows; };

__device__ __forceinline__ bool linear_tile(int nM, int nN, long L, int& pm, int& pn) {
    const int nwg = nM * nN; if (L >= nwg) return false;
    int wgid = (int)L; { const int q = nwg / NXCD, r = nwg % NXCD, xcd = wgid % NXCD, off = wgid / NXCD; wgid = (xcd < r ? xcd * (q + 1) : r * (q + 1) + (xcd - r) * q) + off; }
    const int nig = WGM * nN, gid = wgid / nig, fm = gid * WGM, gsz = (nM - fm) < WGM ? (nM - fm) : WGM;
    pm = fm + ((wgid % nig) % gsz); pn = (wgid % nig) / gsz; return true;
}
__device__ __forceinline__ bool static_tile(int nM, int nN, int G, int c, int i, int& pm, int& pn) { return linear_tile(nM, nN, (long)i * G + c, pm, pn); }

typedef int v8i_t __attribute__((ext_vector_type(8)));
typedef int v4i_t __attribute__((ext_vector_type(4)));
template <class Epi, class Sched, int MODE = 0>
__device__ __forceinline__ void gemm_stream(ldsp lds, const int tid, const Sched& S, const Epi& E) {
    const int wid = __builtin_amdgcn_readfirstlane(tid >> 6), lane = tid & 63, wr = wid >> 2, wc = wid & 3, fr = lane & 15, fq = lane >> 4;
    GU cur, nxt; int ui = 0;
    if (!S.next(0, cur)) return;
    unsigned voffA[2], voffA2[2], voffB[2]; size_t hA, hB;
#define PG8_SETOFF(u) do { int _t = tid; asm volatile("" : "+v"(_t)); _Pragma("unroll") for (int _i = 0; _i < 2; ++_i) { int _R, _C; stage_rc(_t * 16 + _i * 8192, _R, _C); \
        const int _Rb = Epi::PERM ? ((_R & ~31) + perm32(_R & 31)) : _R; voffB[_i] = (unsigned)_Rb * (u).pb + (unsigned)(_C * 2); \
        if (Sched::GATHER) { const unsigned _r0 = (_R < (u).nrows) ? (u).rows[_R] : 0u, _r1 = (_R + HALF < (u).nrows) ? (u).rows[_R + HALF] : 0u; voffA[_i] = _r0 * (u).pa + (unsigned)(_C * 2); voffA2[_i] = _r1 * (u).pa + (unsigned)(_C * 2); } \
        else { voffA[_i] = (unsigned)_R * (u).pa + (unsigned)(_C * 2); } } \
        hA = (size_t)HALF * (u).pa; hB = (size_t)HALF * (u).pb; } while (0)
    PG8_SETOFF(cur);
    const size_t kstep = (size_t)(BK * 2);
    const unsigned ldsw = (unsigned)wid * 1024u;
    bool f8 = (MODE == 1) || (MODE == 2 && cur.f8 != 0);
    int aoff, boff;
#define PG8_SETFRAG() do { int _t = tid; asm volatile("" : "+v"(_t)); const int _fr = _t & 15, _fq = (_t >> 4) & 3; \
        aoff = lds_byte(wr * 64 + _fr, _fq * (f8 ? 16 : 8)); boff = lds_byte(wc * 32 + _fr, _fq * (f8 ? 16 : 8)); } while (0)
    PG8_SETFRAG();
#define PG8_SA(b, h) (((b) * 2 + (h)) * HTB)
#define PG8_SB(b, h) ((4 + (b) * 2 + (h)) * HTB)
#define PG8_STAGE(bufoff, gbase, voff) do { _Pragma("unroll") for (int _i = 0; _i < 2; ++_i) \
        __builtin_amdgcn_global_load_lds((const unsigned*)((const char*)(gbase) + (voff)[_i]), (LAS unsigned*)(lds + (bufoff) + ldsw + _i * 8192), 16, 0, 0); } while (0)
#define PG8_STAGE_A2(bufoff, gbase) do { if (Sched::GATHER) PG8_STAGE(bufoff, gbase, voffA2); else PG8_STAGE(bufoff, (gbase) + hA, voffA); } while (0)
#define PG8_LDA(dst, b, h) do { _Pragma("unroll") for (int m = 0; m < 4; ++m) _Pragma("unroll") for (int k = 0; k < 2; ++k) dst[m][k] = *(const LAS bf16x8*)(lds + PG8_SA(b, h) + aoff + m * 2048 + k * KOFF_); } while (0)
#define PG8_LDB(dst, b, h) do { _Pragma("unroll") for (int n = 0; n < 2; ++n) _Pragma("unroll") for (int k = 0; k < 2; ++k) dst[n][k] = *(const LAS bf16x8*)(lds + PG8_SB(b, h) + boff + n * 2048 + k * KOFF_); } while (0)
#define PG8_PAIR(x) __builtin_shufflevector(__builtin_bit_cast(v4i_t, x[0]), __builtin_bit_cast(v4i_t, x[1]), 0, 1, 2, 3, 4, 5, 6, 7)
#define PG8_MMA_F8(ai, bj, At, Bt) do { __builtin_amdgcn_s_setprio(1); _Pragma("unroll") for (int m = 0; m < 4; ++m) _Pragma("unroll") for (int n = 0; n < 2; ++n) \
            acc[ai][bj][m][n] = __builtin_amdgcn_mfma_scale_f32_16x16x128_f8f6f4(PG8_PAIR(Bt[n]), PG8_PAIR(At[m]), acc[ai][bj][m][n], 0, 0, 0, 0x7f7f7f7f, 0, 0x7f7f7f7f); \
        __builtin_amdgcn_s_setprio(0); } while (0)
#define PG8_MMA_BF(ai, bj, At, Bt) do { __builtin_amdgcn_s_setprio(1); _Pragma("unroll") for (int m = 0; m < 4; ++m) _Pragma("unroll") for (int n = 0; n < 2; ++n) _Pragma("unroll") for (int k = 0; k < 2; ++k) \
            acc[ai][bj][m][n] = __builtin_amdgcn_mfma_f32_16x16x32_bf16(Bt[n][k], At[m][k], acc[ai][bj][m][n], 0, 0, 0); \
        __builtin_amdgcn_s_setprio(0); } while (0)
#define PG8_WAIT_V(n) asm volatile("s_waitcnt vmcnt(" #n ")" ::: "memory")
#define PG8_WAIT_L(n) asm volatile("s_waitcnt lgkmcnt(" #n ")" ::: "memory")
#define PG8_BAR __builtin_amdgcn_s_barrier()
#define PG8_SCHED __builtin_amdgcn_sched_barrier(0)
#define PG8_KLOOP(MMA_, KO_) \
        constexpr int KOFF_ = KO_; \
        _Pragma("unroll 1") \
        for (int t = 0; t < nt; t += 2) { \
            const bool last = (t == nt - 2); \
            const char* a1 = cA + (size_t)(t + 1) * kstep; \
            PG8_LDB(B0, 0, 0); PG8_LDB(B1, 0, 1); PG8_SCHED; PG8_LDA(At, 0, 0); PG8_STAGE_A2(PG8_SA(1, 1), a1); \
            if (last && has_next) PG8_SETOFF(nxt); \
            const char* a2 = last ? nA : cA + (size_t)(t + 2) * kstep; const char* b2 = last ? nB : cB + (size_t)(t + 2) * kstep; \
            const char* a3 = a2 + kstep; const char* b3 = b2 + kstep; \
            PG8_WAIT_V(8); PG8_WAIT_L(0); PG8_BAR; MMA_(0, 0, At, B0); MMA_(0, 1, At, B1); PG8_BAR; PG8_SCHED; \
            PG8_LDA(At, 0, 1); PG8_STAGE(PG8_SB(0, 0), b2, voffB); PG8_STAGE(PG8_SB(0, 1), b2 + hB, voffB); PG8_STAGE(PG8_SA(0, 0), a2, voffA); \
            PG8_WAIT_V(8); PG8_WAIT_L(0); PG8_BAR; MMA_(1, 0, At, B0); MMA_(1, 1, At, B1); PG8_BAR; PG8_SCHED; \
            PG8_LDB(B0, 1, 0); PG8_LDB(B1, 1, 1); PG8_SCHED; PG8_LDA(At, 1, 0); PG8_STAGE_A2(PG8_SA(0, 1), a2); \
            PG8_WAIT_V(8); PG8_WAIT_L(0); PG8_BAR; MMA_(0, 0, At, B0); MMA_(0, 1, At, B1); PG8_BAR; PG8_SCHED; \
            PG8_LDA(At, 1, 1); PG8_STAGE(PG8_SB(1, 0), b3, voffB); PG8_STAGE(PG8_SB(1, 1), b3 + hB, voffB); PG8_STAGE(PG8_SA(1, 0), a3, voffA); \
            PG8_WAIT_V(8); PG8_WAIT_L(0); PG8_BAR; MMA_(1, 0, At, B0); MMA_(1, 1, At, B1); PG8_BAR; PG8_SCHED; \
        }
    f32x4 acc[2][2][4][2];
#pragma unroll
    for (int a = 0; a < 2; ++a)
#pragma unroll
        for (int b = 0; b < 2; ++b)
#pragma unroll
            for (int m = 0; m < 4; ++m)
#pragma unroll
                for (int n = 0; n < 2; ++n) acc[a][b][m][n] = (f32x4){0.f, 0.f, 0.f, 0.f};
    bf16x8 At[4][2], B0[2][2], B1[2][2];
    const char* cA = cur.A; const char* cB = cur.B; int nt = cur.nt;
    PG8_STAGE(PG8_SB(0, 0), cB, voffB); PG8_STAGE(PG8_SB(0, 1), cB + hB, voffB); PG8_STAGE(PG8_SA(0, 0), cA, voffA); PG8_STAGE_A2(PG8_SA(0, 1), cA);
    if (wr == 1) PG8_BAR;
    PG8_WAIT_V(2); PG8_BAR;
    PG8_STAGE(PG8_SB(1, 0), cB + kstep, voffB); PG8_STAGE(PG8_SA(1, 0), cA + kstep, voffA); PG8_STAGE(PG8_SB(1, 1), cB + hB + kstep, voffB);
    PG8_WAIT_V(6); PG8_BAR;
    for (;;) {
        const bool has_next = S.next(ui + 1, nxt);
        const char* nA = has_next ? nxt.A : cA; const char* nB = has_next ? nxt.B : cB;
        if (MODE == 1 || (MODE == 2 && f8)) { PG8_KLOOP(PG8_MMA_F8, 16) } else { PG8_KLOOP(PG8_MMA_BF, 1024) }
        if (wr == 0) PG8_BAR;
        { int tid_ = tid; asm volatile("" : "+v"(tid_)); const int fr_ = tid_ & 15, fq_ = (tid_ >> 4) & 3; E(acc, cur, wr, wc, fr_, fq_, tid_); }
        if (!has_next) break;
#pragma unroll
        for (int a = 0; a < 2; ++a)
#pragma unroll
            for (int b = 0; b < 2; ++b)
#pragma unroll
                for (int m = 0; m < 4; ++m)
#pragma unroll
                    for (int n = 0; n < 2; ++n) acc[a][b][m][n] = (f32x4){0.f, 0.f, 0.f, 0.f};
        cur = nxt; cA = nA; cB = nB; nt = cur.nt; ++ui;
        if (MODE == 2) { f8 = cur.f8 != 0; PG8_SETFRAG(); }
        if (wr == 1) PG8_BAR;
    }
    PG8_WAIT_V(0);
    PG8_BAR;
#undef PG8_SETOFF
#undef PG8_SETFRAG
#undef PG8_SA
#undef PG8_SB
#undef PG8_STAGE
#undef PG8_STAGE_A2
#undef PG8_LDA
#undef PG8_LDB
#undef PG8_MMA_F8
#undef PG8_MMA_BF
#undef PG8_KLOOP
#undef PG8_PAIR
#undef PG8_WAIT_V
#undef PG8_WAIT_L
#undef PG8_BAR
#undef PG8_SCHED
}
}

typedef f32x4 acc_t[2][2][4][2];
__device__ __forceinline__ float sigmoid_f(float x) { return __builtin_amdgcn_rcpf(1.0f + __builtin_amdgcn_exp2f(-x * LOG2E)); }

struct EpiBf16 {
    static constexpr bool PERM = true;
    bf16_t* O; int ldc; float* kmsum; unsigned* kdone = nullptr; float osc = 1.0f;
    __device__ __forceinline__ void operator()(const acc_t& acc, const pg8::GU& u, int wr, int wc, int fr, int fq, int tid) const {
        const int row0 = u.pm * 256 + wr * 64 + fr, col0 = u.pn * 256 + wc * 32 + 8 * fq;
#pragma unroll
        for (int ai = 0; ai < 2; ++ai)
#pragma unroll
            for (int m = 0; m < 4; ++m) { bf16_t* rowp = O + (size_t)(row0 + ai * 128 + m * 16) * ldc + col0;
#pragma unroll
                for (int bj = 0; bj < 2; ++bj) { const f32x4 v0 = acc[ai][bj][m][0] * osc, v1 = acc[ai][bj][m][1] * osc;
                    u32x4 w; w.x = cvtpk(v0[0], v0[1]); w.y = cvtpk(v0[2], v0[3]); w.z = cvtpk(v1[0], v1[1]); w.w = cvtpk(v1[2], v1[3]);
                    *(u32x4*)(rowp + bj * 128) = w; } }
        if (kmsum != nullptr && u.pn == 1) {
#pragma unroll
            for (int bj = 0; bj < 2; ++bj)
#pragma unroll
                for (int n = 0; n < 2; ++n)
#pragma unroll
                    for (int j = 0; j < 4; ++j) {
                        float s = 0.f;
#pragma unroll
                        for (int ai = 0; ai < 2; ++ai)
#pragma unroll
                            for (int m = 0; m < 4; ++m) s += acc[ai][bj][m][n][j];
                        { const int ln = fq * 16 + fr; s += shflx(s, 1, ln); s += shflx(s, 2, ln); s += shflx(s, 4, ln); s += shflx(s, 8, ln); }
                        if (fr == 0) atomicAdd(kmsum + (size_t)u.pm * 256 + bj * 128 + wc * 32 + 8 * fq + 4 * n + j, s);
                    }
            asm volatile("s_waitcnt vmcnt(0)" ::: "memory");
            __builtin_amdgcn_fence(__ATOMIC_RELEASE, "agent");
            if (fq * 16 + fr == 0) (void)__hip_atomic_fetch_add(kdone, 1u, __ATOMIC_RELAXED, __HIP_MEMORY_SCOPE_AGENT);
        }
    }
};
struct EpiFp8 {
    static constexpr bool PERM = true;
    unsigned char* O; int ldc; float osc;
    __device__ __forceinline__ void operator()(const acc_t& acc, const pg8::GU& u, int wr, int wc, int fr, int fq, int tid) const {
        const int row0 = u.pm * 256 + wr * 64 + fr, col0 = u.pn * 256 + wc * 32 + 8 * fq;
#pragma unroll
        for (int ai = 0; ai < 2; ++ai)
#pragma unroll
            for (int m = 0; m < 4; ++m) { unsigned char* rowp = O + (size_t)(row0 + ai * 128 + m * 16) * ldc + col0;
#pragma unroll
                for (int bj = 0; bj < 2; ++bj) { const f32x4 v0 = acc[ai][bj][m][0] * osc, v1 = acc[ai][bj][m][1] * osc;
                    u32x2 w; w.x = pk_fp8x4(v0[0], v0[1], v0[2], v0[3]); w.y = pk_fp8x4(v1[0], v1[1], v1[2], v1[3]);
                    *(u32x2*)(rowp + bj * 128) = w; } }
    }
};
template <bool INF32>
struct EpiResid {
    static constexpr bool PERM = true;
    const float* xin32; const bf16_t* xin16; bf16_t* xout;
    __device__ __forceinline__ void operator()(const acc_t& acc, const pg8::GU& u, int wr, int wc, int fr, int fq, int tid) const {
        const int row0 = u.pm * 256 + wr * 64 + fr, col0 = u.pn * 256 + wc * 32 + 8 * fq;
#pragma unroll
        for (int ai = 0; ai < 2; ++ai)
#pragma unroll
            for (int m = 0; m < 4; ++m) { const size_t off = (size_t)(row0 + ai * 128 + m * 16) * DM + col0;
#pragma unroll
                for (int bj = 0; bj < 2; ++bj) { f32x4 v0 = acc[ai][bj][m][0], v1 = acc[ai][bj][m][1];
                    if (INF32) { v0 += *(const f32x4*)(xin32 + off + bj * 128); v1 += *(const f32x4*)(xin32 + off + bj * 128 + 4); }
                    else { const u32x4 b = *(const u32x4*)(xin16 + off + bj * 128);
                        v0[0] += bf_lo(b.x); v0[1] += bf_hi(b.x); v0[2] += bf_lo(b.y); v0[3] += bf_hi(b.y); v1[0] += bf_lo(b.z); v1[1] += bf_hi(b.z); v1[2] += bf_lo(b.w); v1[3] += bf_hi(b.w); }
                    u32x4 w; w.x = cvtpk(v0[0], v0[1]); w.y = cvtpk(v0[2], v0[3]); w.z = cvtpk(v1[0], v1[1]); w.w = cvtpk(v1[2], v1[3]);
                    *(u32x4*)(xout + off + bj * 128) = w; } }
    }
};
constexpr float GSC = 1.0f / 32.0f;
struct EpiGate {
    static constexpr bool PERM = true;
    bf16_t* merged; unsigned char* sscr;
    __device__ __forceinline__ void operator()(const acc_t& acc, const pg8::GU& u, int wr, int wc, int fr, int fq, int tid) const {
        if ((u.aux & 1) == 0) {
#pragma unroll
            for (int ai = 0; ai < 2; ++ai)
#pragma unroll
                for (int bj = 0; bj < 2; ++bj)
#pragma unroll
                    for (int m = 0; m < 4; ++m) { const f32x4 v0 = acc[ai][bj][m][0], v1 = acc[ai][bj][m][1];
                        u32x4 w; w.x = cvtpk(sigmoid_f(v0[0] * GSC), sigmoid_f(v0[1] * GSC)); w.y = cvtpk(sigmoid_f(v0[2] * GSC), sigmoid_f(v0[3] * GSC)); w.z = cvtpk(sigmoid_f(v1[0] * GSC), sigmoid_f(v1[1] * GSC)); w.w = cvtpk(sigmoid_f(v1[2] * GSC), sigmoid_f(v1[3] * GSC));
                        *(u32x4*)(sscr + ((size_t)(((ai * 2 + bj) * 4 + m) * 512 + tid)) * 16) = w; asm volatile("" ::: "memory"); }
        } else {
            const bool first = (u.aux >> 1) == 0;
            const int row0 = u.pm * 256 + wr * 64 + fr, col0 = u.pn * 256 + wc * 32 + 8 * fq;
            u32x4 sv[2][2][4];
            u32x4 ov[4][2];
#pragma unroll
            for (int ai = 0; ai < 2; ++ai)
#pragma unroll
                for (int bj = 0; bj < 2; ++bj)
#pragma unroll
                    for (int m = 0; m < 4; ++m) sv[ai][bj][m] = *(const u32x4*)(sscr + ((size_t)(((ai * 2 + bj) * 4 + m) * 512 + tid)) * 16);
            if (!first) {
#pragma unroll
                for (int m = 0; m < 4; ++m)
#pragma unroll
                    for (int bj = 0; bj < 2; ++bj) ov[m][bj] = *(const u32x4*)(merged + (size_t)(row0 + m * 16) * DM + col0 + bj * 128);
            }
#pragma unroll
            for (int ai = 0; ai < 2; ++ai) {
                asm volatile("" ::: "memory");
#pragma unroll
                for (int m = 0; m < 4; ++m) { bf16_t* rowp = merged + (size_t)(row0 + ai * 128 + m * 16) * DM + col0;
#pragma unroll
                    for (int bj = 0; bj < 2; ++bj) {
                        const u32x4 sq = sv[ai][bj][m];
                        const f32x4 v0 = acc[ai][bj][m][0], v1 = acc[ai][bj][m][1];
                        float r[8] = {bf_lo(sq.x) * v0[0], bf_hi(sq.x) * v0[1], bf_lo(sq.y) * v0[2], bf_hi(sq.y) * v0[3], bf_lo(sq.z) * v1[0], bf_hi(sq.z) * v1[1], bf_lo(sq.w) * v1[2], bf_hi(sq.w) * v1[3]};
                        if (!first) { const u32x4 o = ov[m][bj];
                            r[0] += bf_lo(o.x); r[1] += bf_hi(o.x); r[2] += bf_lo(o.y); r[3] += bf_hi(o.y); r[4] += bf_lo(o.z); r[5] += bf_hi(o.z); r[6] += bf_lo(o.w); r[7] += bf_hi(o.w); }
                        u32x4 w; w.x = cvtpk(r[0], r[1]); w.y = cvtpk(r[2], r[3]); w.z = cvtpk(r[4], r[5]); w.w = cvtpk(r[6], r[7]);
                        *(u32x4*)(rowp + bj * 128) = w; } }
                asm volatile("" ::: "memory");
                if (ai == 0 && !first) {
#pragma unroll
                    for (int m = 0; m < 4; ++m)
#pragma unroll
                        for (int bj = 0; bj < 2; ++bj) ov[m][bj] = *(const u32x4*)(merged + (size_t)(row0 + 128 + m * 16) * DM + col0 + bj * 128);
                }
            }
        }
    }
};
struct EpiSilu {
    static constexpr bool PERM = true;
    unsigned char* H; float isc;
    __device__ __forceinline__ void operator()(const acc_t& acc, const pg8::GU& u, int wr, int wc, int fr, int fq, int tid) const {
        const int row0 = u.pm * 256 + wr * 64 + fr, col0 = u.pn * 128 + wc * 32 + 8 * fq;
#pragma unroll
        for (int ai = 0; ai < 2; ++ai)
#pragma unroll
            for (int m = 0; m < 4; ++m) { unsigned char* rowp = H + (size_t)(row0 + ai * 128 + m * 16) * DEXP + col0;
                float r[8];
#pragma unroll
                for (int n = 0; n < 2; ++n)
#pragma unroll
                    for (int j = 0; j < 4; ++j) { const float a = acc[ai][0][m][n][j] * isc, g = acc[ai][1][m][n][j] * isc; r[4 * n + j] = a * sigmoid_f(a) * g; }
                u32x2 w; w.x = pk_fp8x4(r[0], r[1], r[2], r[3]); w.y = pk_fp8x4(r[4], r[5], r[6], r[7]);
                *(u32x2*)rowp = w; }
    }
};

struct SchedProj { static constexpr bool GATHER = false; const char* A; const char* B; int G, c;
    __device__ __forceinline__ bool next(int i, pg8::GU& u) const { int pm, pn; const long L = (long)i * G + c;
        if (!pg8::linear_tile(NTOK / 256, INC / 256, L, pm, pn)) return false;
        u.A = A + (size_t)pm * 256 * 2048; u.B = B + (size_t)pn * 256 * 2048; u.pa = 2048; u.pb = 2048; u.nt = 16; u.pm = pm; u.pn = pn; u.aux = 0; u.f8 = 0; return true; } };
struct SchedWo { static constexpr bool GATHER = false; const char* A; const char* B; int G, c;
    __device__ __forceinline__ bool next(int i, pg8::GU& u) const { int pm, pn; if (!pg8::static_tile(NTOK / 256, 4, G, c, i, pm, pn)) return false;
        u.A = A + (size_t)pm * 256 * 2048; u.B = B + (size_t)pn * 256 * 2048; u.pa = 2048; u.pb = 2048; u.nt = 16; u.pm = pm; u.pn = pn; u.aux = 0; u.f8 = 0; return true; } };
struct SchedGate { static constexpr bool GATHER = false; const char* Hh; const char* Oo; const char* Wg; const char* Wbr; int G, c;
    __device__ __forceinline__ bool next(int i, pg8::GU& u) const { int pm, pn; if (!pg8::static_tile(NTOK / 256, 4, G, c, i >> 3, pm, pn)) return false;
        const int sub = i & 7, br = sub >> 1; u.pm = pm; u.pn = pn; u.aux = sub;
        if ((sub & 1) == 0) { u.A = Hh + (size_t)pm * 256 * 1024; u.B = Wg + (size_t)(br * 1024 + pn * 256) * 1024; u.pa = 1024; u.pb = 1024; u.nt = 8; u.f8 = 1; }
        else { u.A = Oo + (size_t)pm * 256 * 2048 + br * 512; u.B = Wbr + (size_t)(br * 1024 + pn * 256) * 512; u.pa = 2048; u.pb = 512; u.nt = 4; u.f8 = 0; }
        return true; } };
constexpr int LDS_MOE = 131072;
constexpr int MOE_LIST_CAP = NTOK;
template <unsigned PA, unsigned PB, int NT, bool GATHER_>
struct SchedMoe { static constexpr bool GATHER = GATHER_; ldsp lds; const char* A; const char* B; int G, c; const unsigned* lists;
    __device__ __forceinline__ bool next(int i, pg8::GU& u) const { const LAS int* tb = (const LAS int*)(lds + LDS_MOE); const int T = __builtin_amdgcn_readfirstlane(tb[0]); const int uu = c + i * G; if (uu >= 4 * T) return false;
        const int tile = uu >> 2, pn = uu & 3, e = __builtin_amdgcn_readfirstlane(tb[1 + tile]);
        u.B = B + (size_t)(e * 1024 + pn * 256) * PB; u.pa = PA; u.pb = PB; u.nt = NT; u.pm = tile; u.pn = pn; u.aux = 0; u.f8 = 0;
        if (GATHER_) { const int first = __builtin_amdgcn_readfirstlane(tb[400 + e]), cnt = __builtin_amdgcn_readfirstlane(tb[440 + e]), r0 = tile * 256 - first;
            u.A = A; u.rows = lists + (size_t)e * MOE_LIST_CAP + r0; u.nrows = cnt - r0 < 256 ? cnt - r0 : 256; }
        else { u.A = A + (size_t)tile * 256 * PA; u.rows = nullptr; u.nrows = 0; }
        return true; } };

struct CvItem { const float* W; int N; unsigned char* dst; int K; float scale; int f8; };
__device__ __forceinline__ void cv_load(const CvItem& c, float (&wv)[32], int lane) {
#pragma unroll
    for (int i = 0; i < 32; ++i) { const int kk = 2 * i + (lane >> 5); wv[i] = c.W[(size_t)kk * c.N + (lane & 31)]; }
}
__device__ __forceinline__ void cv_store(const CvItem& c, const float (&wv)[32], LAS float* scr, int lane) {
#pragma unroll
    for (int i = 0; i < 32; ++i) { const int kk = 2 * i + (lane >> 5); scr[kk * 33 + (lane & 31)] = wv[i] * c.scale; }
    LDS_WAIT(); asm volatile("" ::: "memory");
    if (c.f8) {
        const int n = lane >> 1;
#pragma unroll
        for (int j = 0; j < 2; ++j) { const int cc = (lane & 1) * 2 + j; const LAS float* s = scr + (16 * cc) * 33 + n;
            u32x4 o; o.x = pk_fp8x4(s[0 * 33], s[1 * 33], s[2 * 33], s[3 * 33]); o.y = pk_fp8x4(s[4 * 33], s[5 * 33], s[6 * 33], s[7 * 33]);
            o.z = pk_fp8x4(s[8 * 33], s[9 * 33], s[10 * 33], s[11 * 33]); o.w = pk_fp8x4(s[12 * 33], s[13 * 33], s[14 * 33], s[15 * 33]);
            *(u32x4*)(c.dst + (size_t)n * c.K + 16 * cc) = o; }
    } else {
        const int cc = lane & 7;
#pragma unroll
        for (int j = 0; j < 4; ++j) { const int n = (lane >> 3) + 8 * j; const LAS float* s = scr + (8 * cc) * 33 + n;
            u32x4 o; o.x = cvtpk(s[0 * 33], s[1 * 33]); o.y = cvtpk(s[2 * 33], s[3 * 33]); o.z = cvtpk(s[4 * 33], s[5 * 33]); o.w = cvtpk(s[6 * 33], s[7 * 33]);
            *(u32x4*)(c.dst + ((size_t)n * c.K + 8 * cc) * 2) = o; }
    }
    LDS_WAIT(); asm volatile("" ::: "memory");
}
__device__ __forceinline__ void ph_convert(const Frame& F, int l) {
    LAS float* scr = (LAS float*)(F.lds + F.wave * 16384);
    const int gw = F.bid * 8 + F.wave, NGW = F.G * 8;
    const float* w_in = F.in[3] + (size_t)l * DM * INC; const float* w_gate = F.in[10] + (size_t)l * 4 * DM * DM; const float* w_br = F.in[11] + (size_t)l * 4 * 256 * DM;
    const float* w_o = F.in[12] + (size_t)l * DM * DM; const float* w1 = F.in[18] + (size_t)l * NEXP * DM * DEXP; const float* w3 = F.in[19] + (size_t)l * NEXP * DM * DEXP; const float* w2 = F.in[20] + (size_t)l * NEXP * DEXP * DM;
    unsigned char* win_t = F.ws + WS_WIN; unsigned char* wg_t = F.ws + WS_WG; unsigned char* wbr_t = F.ws + WS_WBR; unsigned char* wo_t = F.ws + WS_WO;
    unsigned char* w13_t = F.ws + WS_W13; unsigned char* w2_t = F.ws + WS_W2;
    constexpr int I_IN = 16 * 88, I_G = 4 * 16 * 32, I_BR = 4 * 4 * 32, I_O = 16 * 32, I_1 = NEXP * 16 * 16, I_2 = NEXP * 8 * 32;
    constexpr int NITEMS = I_IN + I_G + I_BR + I_O + 2 * I_1 + I_2;
#define CV_DECODE(it_, c_) do { int r = (it_); \
        if (r < I_IN) { const int kb = r / 88, nb = r % 88, n0 = nb * 32, ct = n0 >> 8; \
            c_.scale = (ct == 0 || ct == 6 || ct == 9) ? 0.125f * LOG2E : (ct == 3 ? 0.17677669529663687f * LOG2E : 1.0f);     \
            c_.W = w_in + (size_t)(kb * 64) * INC + n0; c_.N = INC; c_.dst = win_t + ((size_t)n0 * DM + kb * 64) * 2; c_.K = DM; c_.f8 = 0; break; } r -= I_IN; \
        if (r < I_G) { const int i = r / 512, q = r % 512, kb = q / 32, nb = q % 32; \
            c_.W = w_gate + (size_t)i * DM * DM + (size_t)(kb * 64) * DM + nb * 32; c_.N = DM; c_.dst = wg_t + (size_t)(i * 1024 + nb * 32) * DM + kb * 64; c_.K = DM; c_.scale = 32.0f; c_.f8 = 1; break; } r -= I_G; \
        if (r < I_BR) { const int i = r / 128, q = r % 128, kb = q / 32, nb = q % 32; \
            c_.W = w_br + (size_t)i * 256 * DM + (size_t)(kb * 64) * DM + nb * 32; c_.N = DM; c_.dst = wbr_t + ((size_t)(i * 1024 + nb * 32) * 256 + kb * 64) * 2; c_.K = 256; c_.scale = 1.0f; c_.f8 = 0; break; } r -= I_BR; \
        if (r < I_O) { const int kb = r / 32, nb = r % 32; \
            c_.W = w_o + (size_t)(kb * 64) * DM + nb * 32; c_.N = DM; c_.dst = wo_t + ((size_t)(nb * 32) * DM + kb * 64) * 2; c_.K = DM; c_.scale = 1.0f; c_.f8 = 0; break; } r -= I_O; \
        if (r < 2 * I_1) { const int which = r / I_1, q = r % I_1, e = q / 256, qq = q % 256, kb = qq / 16, nb = qq % 16, n0 = nb * 32; \
            const int drow = e * 1024 + (n0 >> 7) * 256 + (n0 & 127) + which * 128; \
            c_.W = (which ? w3 : w1) + (size_t)e * DM * DEXP + (size_t)(kb * 64) * DEXP + n0; c_.N = DEXP; c_.dst = w13_t + (size_t)drow * DM + kb * 64; c_.K = DM; c_.scale = 32.0f; c_.f8 = 1; break; } r -= 2 * I_1; \
        { const int e = r / 256, qq = r % 256, kb = qq / 32, nb = qq % 32; \
            c_.W = w2 + (size_t)e * DEXP * DM + (size_t)(kb * 64) * DM + nb * 32; c_.N = DM; c_.dst = w2_t + (size_t)(e * 1024 + nb * 32) * DEXP + kb * 64; c_.K = DEXP; c_.scale = 16.0f; c_.f8 = 1; } } while (0)
    if (gw >= NITEMS) return;
    CvItem cur, nxt; float wv[32], wn[32];
    CV_DECODE(gw, cur); cv_load(cur, wv, F.lane);
    for (int it = gw; it < NITEMS; it += NGW) {
        const bool more = it + NGW < NITEMS;
        if (more) { CV_DECODE(it + NGW, nxt); cv_load(nxt, wn, F.lane); }
        cv_store(cur, wv, scr, F.lane);
        if (more) { cur = nxt;
#pragma unroll
            for (int i = 0; i < 32; ++i) wv[i] = wn[i]; }
    }
#undef CV_DECODE
}
__device__ __forceinline__ float lam_init_of(int l) { return l == 0 ? 0.2f : 0.35550906f; }
__device__ __forceinline__ void ph_lam(const Frame& F) {
    if (F.bid == 0 && F.wave == 0) {
        for (int l = 0; l < DEPTH; ++l) {
            float a = 0.f, b = 0.f;
            if (F.lane < 32) { a = F.in[4][l * 32 + F.lane] * F.in[5][l * 32 + F.lane]; b = F.in[6][l * 32 + F.lane] * F.in[7][l * 32 + F.lane]; }
            a = wave_sum(a, F.lane); b = wave_sum(b, F.lane);
            if (F.lane == 0) F.ctl[CW_LAM + l] = __float_as_uint(__expf(a) - __expf(b) + lam_init_of(l));
        }
    }
}
__device__ __forceinline__ void ph_norm(const Frame& F, const float* x, const float* g, bf16_t* h, unsigned char* h8) {
    const int gw = F.bid * 8 + F.wave, NGW = F.G * 8;
    f32x4 gv[4];
#pragma unroll
    for (int j = 0; j < 4; ++j) gv[j] = *(const f32x4*)(g + 4 * F.lane + 256 * j);
    for (int m = gw; m < NTOK; m += NGW) {
        const f32x4* xr = (const f32x4*)(x + (size_t)m * DM) + F.lane;
        f32x4 v[4]; float s = 0.f;
#pragma unroll
        for (int j = 0; j < 4; ++j) { v[j] = xr[64 * j]; s += (v[j].x * v[j].x + v[j].y * v[j].y) + (v[j].z * v[j].z + v[j].w * v[j].w); }
        const float rstd = 1.0f / sqrtf(wave_sum(s, F.lane) * (1.0f / DM) + NORM_EPS);
        u32x2* o8 = (u32x2*)(h + (size_t)m * DM) + F.lane;
        unsigned* o4 = (unsigned*)(h8 + (size_t)m * DM) + F.lane;
#pragma unroll
        for (int j = 0; j < 4; ++j) { const f32x4 y = v[j] * rstd * gv[j]; u32x2 w; w.x = cvtpk(y.x, y.y); w.y = cvtpk(y.z, y.w); o8[64 * j] = w; o4[64 * j] = pk_fp8x4(y.x, y.y, y.z, y.w); }
    }
}
constexpr int R_LD = 1028;
constexpr int R_WG = 0, R_WE = 4 * R_LD * 4, R_BIAS = R_WE + 32 * R_LD * 4;
__device__ __forceinline__ void ph_route(const Frame& F, int l, const bf16_t* x2, unsigned char* h2, unsigned* tok, unsigned* lists) {
    const float* wrg = F.in[14] + (size_t)l * DM * 4; const float* brg = F.in[15] + l * 4; const float* wre = F.in[16] + (size_t)l * DM * NEXP; const float* bre = F.in[17] + l * NEXP;
    const float* g = F.in[13] + (size_t)l * DM;
    LAS float* Lg = (LAS float*)(F.lds + R_WG); LAS float* Le = (LAS float*)(F.lds + R_WE); LAS float* Lb = (LAS float*)(F.lds + R_BIAS);
    {
        f32x4 wv[2 + 16];
#pragma unroll
        for (int i = 0; i < 2; ++i) wv[i] = *(const f32x4*)(wrg + 4 * (F.tid + 512 * i));
#pragma unroll
        for (int i = 0; i < 16; ++i) wv[2 + i] = *(const f32x4*)(wre + 4 * (F.tid + 512 * i));
#pragma unroll
        for (int i = 0; i < 2; ++i) { const int c = F.tid + 512 * i; Lg[0 * R_LD + c] = wv[i].x; Lg[1 * R_LD + c] = wv[i].y; Lg[2 * R_LD + c] = wv[i].z; Lg[3 * R_LD + c] = wv[i].w; }
#pragma unroll
        for (int i = 0; i < 16; ++i) { const int idx = 4 * (F.tid + 512 * i), c = idx >> 5, j = idx & 31; Le[(j + 0) * R_LD + c] = wv[2 + i].x; Le[(j + 1) * R_LD + c] = wv[2 + i].y; Le[(j + 2) * R_LD + c] = wv[2 + i].z; Le[(j + 3) * R_LD + c] = wv[2 + i].w; }
    }
    if (F.tid < 4) Lb[F.tid] = brg[F.tid]; else if (F.tid < 36) Lb[F.tid] = bre[F.tid - 4];
    __syncthreads();
    unsigned* cnt = F.ctl + CW_CNT + l * 32 * 64;
    const int gw = F.bid * 8 + F.wave, NGW = F.G * 8;
    f32x4 gv[4];
#pragma unroll
    for (int j = 0; j < 4; ++j) gv[j] = *(const f32x4*)(g + 4 * F.lane + 256 * j);
    u32x2 xn[4];
    if (gw < NTOK) { const u32x2* xr0 = (const u32x2*)(x2 + (size_t)gw * DM) + F.lane;
#pragma unroll
        for (int j = 0; j < 4; ++j) xn[j] = xr0[64 * j]; }
    int pm_ = -1; unsigned pea = 0u, peb = 0u, ppa = 0u, ppb = 0u; float pg0 = 0.f, pg1 = 0.f;
#define ROUTE_RETIRE() do { if (pm_ >= 0 && F.lane == 0) { u32x4 t; t.x = (pea << 24) | ppa; t.y = (peb << 24) | ppb; t.z = __float_as_uint(pg0); t.w = __float_as_uint(pg1); \
            *(u32x4*)(tok + (size_t)pm_ * 4) = t; lists[(size_t)pea * MOE_LIST_CAP + ppa] = (unsigned)pm_; lists[(size_t)peb * MOE_LIST_CAP + ppb] = (unsigned)pm_; } } while (0)
    for (int m = gw; m < NTOK; m += NGW) {
        f32x4 v[4]; float s = 0.f;
#pragma unroll
        for (int j = 0; j < 4; ++j) { const u32x2 xw = xn[j]; v[j].x = bf_lo(xw.x); v[j].y = bf_hi(xw.x); v[j].z = bf_lo(xw.y); v[j].w = bf_hi(xw.y); s += (v[j].x * v[j].x + v[j].y * v[j].y) + (v[j].z * v[j].z + v[j].w * v[j].w); }
        if (m + NGW < NTOK) { const u32x2* xr1 = (const u32x2*)(x2 + (size_t)(m + NGW) * DM) + F.lane;
#pragma unroll
            for (int j = 0; j < 4; ++j) xn[j] = xr1[64 * j]; }
        const float rstd = 1.0f / sqrtf(wave_sum(s, F.lane) * (1.0f / DM) + NORM_EPS);
        unsigned* o4 = (unsigned*)(h2 + (size_t)m * DM) + F.lane;
#pragma unroll
        for (int j = 0; j < 4; ++j) { v[j] = v[j] * rstd * gv[j]; o4[64 * j] = pk_fp8x4(v[j].x, v[j].y, v[j].z, v[j].w); }
        float gl[4];
#pragma unroll
        for (int q = 0; q < 4; ++q) { float a = 0.f;
#pragma unroll
            for (int j = 0; j < 4; ++j) { const f32x4 w = *(const LAS f32x4*)(Lg + q * R_LD + 4 * F.lane + 256 * j); a += (v[j].x * w.x + v[j].y * w.y) + (v[j].z * w.z + v[j].w * w.w); }
            gl[q] = wave_sum(a, F.lane) + Lb[q]; }
        int grp = 0; float gmax = gl[0];
#pragma unroll
        for (int q = 1; q < 4; ++q) if (gl[q] > gmax) { gmax = gl[q]; grp = q; }
        float den = 0.f;
#pragma unroll
        for (int q = 0; q < 4; ++q) den += __expf(gl[q] - gmax);
        const float pgrp = 1.0f / den;
        grp = __builtin_amdgcn_readfirstlane(grp);
        float el[8];
#pragma unroll
        for (int q = 0; q < 8; ++q) { float a = 0.f; const LAS float* wrow = Le + (grp * 8 + q) * R_LD + 4 * F.lane;
#pragma unroll
            for (int j = 0; j < 4; ++j) { const f32x4 w = *(const LAS f32x4*)(wrow + 256 * j); a += (v[j].x * w.x + v[j].y * w.y) + (v[j].z * w.z + v[j].w * w.w); }
            el[q] = wave_sum(a, F.lane) + Lb[4 + grp * 8 + q]; }
        int i0 = 0; float v0 = el[0];
#pragma unroll
        for (int q = 1; q < 8; ++q) if (el[q] > v0) { v0 = el[q]; i0 = q; }
        int i1 = -1; float v1 = -INFINITY;
#pragma unroll
        for (int q = 0; q < 8; ++q) if (q != i0 && el[q] > v1) { v1 = el[q]; i1 = q; }
        const float e1 = __expf(v1 - v0), g0 = pgrp / (1.0f + e1), g1 = pgrp * e1 / (1.0f + e1);
        ROUTE_RETIRE();
        pea = (unsigned)(grp * 8 + i0); peb = (unsigned)(grp * 8 + i1); pg0 = g0; pg1 = g1; pm_ = m;
        if (F.lane == 0) {
            ppa = __hip_atomic_fetch_add(cnt + pea * 64, 1u, __ATOMIC_RELAXED, __HIP_MEMORY_SCOPE_AGENT);
            ppb = __hip_atomic_fetch_add(cnt + peb * 64, 1u, __ATOMIC_RELAXED, __HIP_MEMORY_SCOPE_AGENT);
        }
    }
    ROUTE_RETIRE();
#undef ROUTE_RETIRE
}
__device__ __forceinline__ void moe_tables(const Frame& F, int l) {
    LAS int* tb = (LAS int*)(F.lds + LDS_MOE);
    if (F.tid < NEXP) tb[440 + F.tid] = (int)__hip_atomic_load(F.ctl + CW_CNT + l * 32 * 64 + F.tid * 64, __ATOMIC_RELAXED, __HIP_MEMORY_SCOPE_AGENT);
    __syncthreads();
    if (F.tid == 0) {
        int t = 0;
        for (int e = 0; e < NEXP; ++e) { const int c = tb[440 + e]; const int nt = (c + 255) >> 8; tb[400 + e] = t * 256; for (int k = 0; k < nt; ++k) tb[1 + t + k] = e; t += nt; }
        tb[0] = t;
    }
    __syncthreads();
}
__device__ __forceinline__ void ph_combine(const Frame& F, int l, const bf16_t* x2, const unsigned char* y, const unsigned* tok, const float* g, float* xfinal, bf16_t* xout, bf16_t* h, unsigned char* h8, bool final_) {
    moe_tables(F, l);
    const LAS int* tb = (const LAS int*)(F.lds + LDS_MOE);
    const int gw = F.bid * 8 + F.wave, NGW = F.G * 8;
    f32x4 gv[4];
#pragma unroll
    for (int j = 0; j < 4; ++j) gv[j] = *(const f32x4*)(g + 4 * F.lane + 256 * j);
    u32x4 tk1 = (u32x4){0u, 0u, 0u, 0u}, tk2 = tk1;
    u32x2 xw0[4], xw1[4]; unsigned ya0[4], yb0[4], ya1[4], yb1[4]; float g00 = 0.f, g10 = 0.f, g01 = 0.f, g11 = 0.f;
#define FIN_ISSUE(mrow, tk_, xw_, ya_, yb_, ga_, gb_) do { u32x4 t_ = tk_; \
        t_.x = (unsigned)tb[400 + (t_.x >> 24)] + (t_.x & 0xffffffu); t_.y = (unsigned)tb[400 + (t_.y >> 24)] + (t_.y & 0xffffffu);     \
        ga_ = __uint_as_float(t_.z) * 0.125f; gb_ = __uint_as_float(t_.w) * 0.125f;     \
        const u32x2* xr_ = (const u32x2*)(x2 + (size_t)(mrow) * DM) + F.lane; \
        const unsigned* y0_ = (const unsigned*)(y + (size_t)t_.x * DM) + F.lane; const unsigned* y1_ = (const unsigned*)(y + (size_t)t_.y * DM) + F.lane; \
        _Pragma("unroll") for (int j = 0; j < 4; ++j) { xw_[j] = xr_[64 * j]; ya_[j] = y0_[64 * j]; yb_[j] = y1_[64 * j]; } } while (0)
    if (gw < NTOK) { tk1 = *(const u32x4*)(tok + (size_t)gw * 4); FIN_ISSUE(gw, tk1, xw1, ya1, yb1, g01, g11); }
    if (gw + NGW < NTOK) tk1 = *(const u32x4*)(tok + (size_t)(gw + NGW) * 4);
    for (int m = gw; m < NTOK; m += NGW) {
#pragma unroll
        for (int j = 0; j < 4; ++j) { xw0[j] = xw1[j]; ya0[j] = ya1[j]; yb0[j] = yb1[j]; }
        g00 = g01; g10 = g11;
        if (m + 2 * NGW < NTOK) tk2 = *(const u32x4*)(tok + (size_t)(m + 2 * NGW) * 4);
        if (m + NGW < NTOK) FIN_ISSUE(m + NGW, tk1, xw1, ya1, yb1, g01, g11);
        tk1 = tk2;
        const float g0 = g00, g1 = g10;
        f32x4 v[4]; float s = 0.f;
#pragma unroll
        for (int j = 0; j < 4; ++j) { const u32x2 xw = xw0[j]; v[j].x = bf_lo(xw.x); v[j].y = bf_hi(xw.x); v[j].z = bf_lo(xw.y); v[j].w = bf_hi(xw.y); const unsigned a = ya0[j], b = yb0[j];
            const f32x2_t a0 = __builtin_amdgcn_cvt_pk_f32_fp8((int)a, false), a1 = __builtin_amdgcn_cvt_pk_f32_fp8((int)a, true), b0 = __builtin_amdgcn_cvt_pk_f32_fp8((int)b, false), b1 = __builtin_amdgcn_cvt_pk_f32_fp8((int)b, true);
            v[j].x += g0 * a0.x + g1 * b0.x; v[j].y += g0 * a0.y + g1 * b0.y; v[j].z += g0 * a1.x + g1 * b1.x; v[j].w += g0 * a1.y + g1 * b1.y;
            s += (v[j].x * v[j].x + v[j].y * v[j].y) + (v[j].z * v[j].z + v[j].w * v[j].w); }
        const float rstd = 1.0f / sqrtf(wave_sum(s, F.lane) * (1.0f / DM) + NORM_EPS);
        if (final_) {
            f32x4* xo = (f32x4*)(xfinal + (size_t)m * DM) + F.lane;
#pragma unroll
            for (int j = 0; j < 4; ++j) xo[64 * j] = v[j] * rstd * gv[j];
        } else {
            u32x2* xo = (u32x2*)(xout + (size_t)m * DM) + F.lane;
            u32x2* o8 = (u32x2*)(h + (size_t)m * DM) + F.lane;
            unsigned* o4 = (unsigned*)(h8 + (size_t)m * DM) + F.lane;
#pragma unroll
            for (int j = 0; j < 4; ++j) { u32x2 xw; xw.x = cvtpk(v[j].x, v[j].y); xw.y = cvtpk(v[j].z, v[j].w); xo[64 * j] = xw; const f32x4 y = v[j] * rstd * gv[j]; u32x2 w; w.x = cvtpk(y.x, y.y); w.y = cvtpk(y.z, y.w); o8[64 * j] = w; o4[64 * j] = pk_fp8x4(y.x, y.y, y.z, y.w); }
        }
    }
#undef FIN_ISSUE
}
namespace att {
constexpr int A_KV = 0  , A_OST = 65536, A_WSF = 131072, A_TAB = 133120, A_KM = 139264, A_MISC = 147456  ;
#define BAR_L() asm volatile("s_waitcnt lgkmcnt(0)\n\ts_barrier" ::: "memory")
#define WAIT_BAR(N) asm volatile("s_waitcnt vmcnt(" #N ") lgkmcnt(0)\n\ts_barrier" ::: "memory")
__device__ __forceinline__ void glds16(const void* gsrc, unsigned lds_dst) { unsigned keep;
    asm volatile("s_mov_b32 %0, m0\n\ts_mov_b32 m0, %2\n\ts_nop 0\n\tglobal_load_lds_dwordx4 %1, off\n\ts_mov_b32 m0, %0" : "=&s"(keep) : "v"(gsrc), "s"(lds_dst) : "memory"); }
constexpr float NEG_BIG = -1.0e30f;
__device__ __forceinline__ int crow(int r, int hi) { return (r & 3) + 8 * (r >> 2) + 4 * hi; }
__device__ __forceinline__ s16x4 vtr(ldsp p) { return __builtin_bit_cast(s16x4, __builtin_amdgcn_ds_read_tr16_b64_v4i16((LAS s16x4*)p)); }
__device__ __forceinline__ float swapmax(float m) { auto rr = __builtin_amdgcn_permlane32_swap(__float_as_uint(m), __float_as_uint(m), false, false); return fmaxf(__uint_as_float(rr[0]), __uint_as_float(rr[1])); }
__device__ __forceinline__ float swapsum(float m) { auto rr = __builtin_amdgcn_permlane32_swap(__float_as_uint(m), __float_as_uint(m), false, false); return __uint_as_float(rr[0]) + __uint_as_float(rr[1]); }

struct Ctx { ldsp lds; const bf16_t* proj; bf16_t* o; int tid, lane, wid, r32, hi, shadow; };
#ifndef DPROBE
#define DPROBE 0
#endif

__device__ __forceinline__ int rel_bucket(int n) { if (n < 16) return n; int v = 16 + (int)(__logf((float)n / 16.0f) / 2.0794415416798357f * 16.0f); return v > 31 ? 31 : v; }
__device__ __forceinline__ void build_tables(const Ctx& c, const float* rel_bias) {
    LAS float* tab = (LAS float*)(c.lds + A_TAB);
    for (int idx = c.tid; idx < 12 * 128; idx += 512) { const int h = idx >> 7, i = idx & 127; float v = rel_bias[rel_bucket(i) * 12 + h]; if (h < 8) v -= rel_bias[31 * 12 + h]; tab[idx] = v * LOG2E; }
}
__device__ __forceinline__ void glds16s(const void* sbase_, unsigned voff, unsigned lds_dst) { unsigned keep;
    const unsigned long long pk_ = (unsigned long long)sbase_; const void* sbase = (const void*)(((unsigned long long)(unsigned)__builtin_amdgcn_readfirstlane((int)(pk_ >> 32)) << 32) | (unsigned)__builtin_amdgcn_readfirstlane((int)pk_));
    asm volatile("s_mov_b32 %0, m0\n\ts_mov_b32 m0, %3\n\ts_nop 0\n\tglobal_load_lds_dwordx4 %1, %2\n\ts_mov_b32 m0, %0" : "=&s"(keep) : "v"(voff), "s"(sbase), "s"(lds_dst) : "memory"); }
template <bool DIFF>
__device__ __forceinline__ void stage_kv(const Ctx& c, int slot, long krow0, int kcol, int kcol2, int vcol) {
    const unsigned base = (unsigned)(uintptr_t)c.lds + A_KV + slot * 16384 + c.wid * 1024;
    const int kc = DIFF ? (c.wid < 4 ? kcol + c.wid * 8 : kcol2 + (c.wid - 4) * 8) : kcol + c.wid * 8;
    const bf16_t* kb = c.proj + (size_t)krow0 * INC + kc;
    const bf16_t* vb = c.proj + (size_t)(krow0 + 16 * (c.wid & 3)) * INC + vcol + (c.wid >> 2) * 32;
    glds16s(kb, (unsigned)c.lane * (INC * 2), (unsigned)__builtin_amdgcn_readfirstlane(base));
    glds16s(vb, (unsigned)(c.lane >> 2) * (INC * 2) + (unsigned)(c.lane & 3) * 16u, (unsigned)__builtin_amdgcn_readfirstlane(base + 8192));
}
struct KVB { unsigned long long k, v; };
__device__ __forceinline__ unsigned long long uni64(const void* p) { const unsigned long long q = (unsigned long long)p; return ((unsigned long long)(unsigned)__builtin_amdgcn_readfirstlane((int)(q >> 32)) << 32) | (unsigned)__builtin_amdgcn_readfirstlane((int)q); }
template <bool DIFF>
__device__ __forceinline__ KVB kv_base(const Ctx& c, long rowbase, int kcol, int kcol2, int vcol) {
    const int kc = DIFF ? (c.wid < 4 ? kcol + c.wid * 8 : kcol2 + (c.wid - 4) * 8) : kcol + c.wid * 8;
    KVB b; b.k = uni64(c.proj + (size_t)rowbase * INC + kc); b.v = uni64(c.proj + (size_t)(rowbase + 16 * (c.wid & 3)) * INC + vcol + (c.wid >> 2) * 32); return b;
}
__device__ __forceinline__ void stage_kvb(const Ctx& c, int slot, const KVB& b, int trow  ) {
    const unsigned base = (unsigned)(uintptr_t)c.lds + A_KV + slot * 16384 + c.wid * 1024;
    const unsigned off = (unsigned)__builtin_amdgcn_readfirstlane(trow) * (unsigned)(INC * 2);
    glds16s((const void*)(b.k + off), (unsigned)c.lane * (INC * 2), (unsigned)__builtin_amdgcn_readfirstlane(base));
    glds16s((const void*)(b.v + off), (unsigned)(c.lane >> 2) * (INC * 2) + (unsigned)(c.lane & 3) * 16u, (unsigned)__builtin_amdgcn_readfirstlane(base + 8192));
}
__device__ __forceinline__ bf16x8 kone_frag(int hi) { u32x4 w; w.x = hi == 0 ? 0x3F80u : 0u; w.y = 0u; w.z = 0u; w.w = 0u; return __builtin_bit_cast(bf16x8, w); }
__device__ __forceinline__ unsigned qx_frag(float m, int hi) { return hi == 0 ? (cvtpk(-m, 0.f) & 0xffffu) : 0u; }
__device__ __forceinline__ float bf_round(float x) { return bf_lo(cvtpk(x, 0.f)); }
template <int ND, bool FOLD>
__device__ __forceinline__ void qk_tile(f32x16& p0, f32x16& p1, ldsp kslot, const bf16x8* qf, int r32, int hi, unsigned qxw = 0u) {
    ldsp kb = kslot + hi * 1024 + r32 * 16;
    bf16x8 b0[ND], b1[ND];
#pragma unroll
    for (int d0 = 0; d0 < ND; ++d0) { b0[d0] = *(const LAS bf16x8*)(kb + d0 * 2048); b1[d0] = *(const LAS bf16x8*)(kb + d0 * 2048 + 512); }
    __builtin_amdgcn_sched_barrier(0);
    p0 = (f32x16){}; p1 = (f32x16){};
    if (FOLD) { const bf16x8 k1 = kone_frag(hi); u32x4 qw; qw.x = qxw; qw.y = 0u; qw.z = 0u; qw.w = 0u; const bf16x8 qx = __builtin_bit_cast(bf16x8, qw); p0 = __builtin_amdgcn_mfma_f32_32x32x16_bf16(k1, qx, p0, 0, 0, 0); p1 = __builtin_amdgcn_mfma_f32_32x32x16_bf16(k1, qx, p1, 0, 0, 0); }
#pragma unroll
    for (int d0 = 0; d0 < ND; ++d0) {
        p0 = __builtin_amdgcn_mfma_f32_32x32x16_bf16(b0[d0], qf[d0], p0, 0, 0, 0);
        p1 = __builtin_amdgcn_mfma_f32_32x32x16_bf16(b1[d0], qf[d0], p1, 0, 0, 0);
    }
    __builtin_amdgcn_sched_barrier(0);
}
__device__ __forceinline__ void pack_p(const f32x16& p0, const f32x16& p1, bf16x8 (&pa)[4]) {
    u32x4 w;
    w.x = cvtpk(p0[0], p0[1]); w.y = cvtpk(p0[2], p0[3]); w.z = cvtpk(p0[4], p0[5]); w.w = cvtpk(p0[6], p0[7]); pa[0] = __builtin_bit_cast(bf16x8, w);
    w.x = cvtpk(p0[8], p0[9]); w.y = cvtpk(p0[10], p0[11]); w.z = cvtpk(p0[12], p0[13]); w.w = cvtpk(p0[14], p0[15]); pa[1] = __builtin_bit_cast(bf16x8, w);
    w.x = cvtpk(p1[0], p1[1]); w.y = cvtpk(p1[2], p1[3]); w.z = cvtpk(p1[4], p1[5]); w.w = cvtpk(p1[6], p1[7]); pa[2] = __builtin_bit_cast(bf16x8, w);
    w.x = cvtpk(p1[8], p1[9]); w.y = cvtpk(p1[10], p1[11]); w.z = cvtpk(p1[12], p1[13]); w.w = cvtpk(p1[14], p1[15]); pa[3] = __builtin_bit_cast(bf16x8, w);
}
template <int NM>
__device__ __forceinline__ void pv_tile(f32x16 (&oa)[2], f32x16 (&ob)[2], ldsp vslot, const bf16x8 (&pa)[4], const bf16x8 (&pb)[4], int lane, int hi) {
    ldsp vb = vslot + ((lane >> 4) & 1) * 32 + (lane & 3) * 8 + (4 * hi + ((lane & 15) >> 2)) * 64;
#pragma unroll
    for (int d0 = 0; d0 < 2; ++d0) {
        s16x4 lo[4], hh[4];
#pragma unroll
        for (int ks = 0; ks < 4; ++ks) { lo[ks] = vtr(vb + d0 * 4096 + ks * 1024); hh[ks] = vtr(vb + d0 * 4096 + ks * 1024 + 512); }
        __builtin_amdgcn_sched_barrier(0);
#pragma unroll
        for (int ks = 0; ks < 4; ++ks) {
            const bf16x8 vf = (bf16x8){lo[ks][0], lo[ks][1], lo[ks][2], lo[ks][3], hh[ks][0], hh[ks][1], hh[ks][2], hh[ks][3]};
            oa[d0] = __builtin_amdgcn_mfma_f32_32x32x16_bf16(pa[ks], vf, oa[d0], 0, 0, 0);
            if (NM == 2) ob[d0] = __builtin_amdgcn_mfma_f32_32x32x16_bf16(pb[ks], vf, ob[d0], 0, 0, 0);
        }
        __builtin_amdgcn_sched_barrier(0);
    }
}
__device__ __forceinline__ void mask_bias(f32x16& p0, f32x16& p1, int dbase, int hi, const LAS float* tab, bool lookup, int tmax, bool causal, bool window, bool rowoff) {
#pragma unroll
    for (int r = 0; r < 16; ++r) {
        const int d0 = dbase - crow(r, hi), d1 = d0 - 32;
        if (lookup) { const int i0 = d0 < 0 ? 0 : (d0 > tmax ? tmax : d0), i1 = d1 < 0 ? 0 : (d1 > tmax ? tmax : d1); p0[r] += tab[i0]; p1[r] += tab[i1]; }
        if (causal) { if (d0 < 0) p0[r] = -INFINITY; if (d1 < 0) p1[r] = -INFINITY; }
        if (window) { if (d0 >= 128) p0[r] = -INFINITY; if (d1 >= 128) p1[r] = -INFINITY; }
        if (rowoff) { p0[r] = -INFINITY; p1[r] = -INFINITY; }
    }
}
__device__ __forceinline__ float max3f(float a, float b, float c) { float r; asm("v_max3_f32 %0, %1, %2, %3" : "=v"(r) : "v"(a), "v"(b), "v"(c)); return r; }
__device__ __forceinline__ void softmax_tile(f32x16& p0, f32x16& p1, float& m, float& l, f32x16 (&o)[2], LAS float* wsf, int r32, int hi, bf16x8 (&pa)[4], unsigned& qx) {
    float ra = max3f(p0[0], p1[0], p0[1]), rb = max3f(p0[4], p1[4], p0[5]), rc = max3f(p0[8], p1[8], p0[9]), rd = max3f(p0[12], p1[12], p0[13]);
    ra = max3f(ra, p1[1], p0[2]); rb = max3f(rb, p1[5], p0[6]); rc = max3f(rc, p1[9], p0[10]); rd = max3f(rd, p1[13], p0[14]);
    ra = max3f(ra, p1[2], p0[3]); rb = max3f(rb, p1[6], p0[7]); rc = max3f(rc, p1[10], p0[11]); rd = max3f(rd, p1[14], p0[15]);
    ra = max3f(ra, p1[3], rb); rc = max3f(rc, p1[7], rd);
    float rm = max3f(ra, rc, p1[11]); rm = max3f(rm, p1[15], p1[15]);
    rm = swapmax(rm);
    const bool upd = (rm > 0.f) || (l == 0.f && rm > -INFINITY);
    if (__any(upd)) {
        const float mn = upd ? bf_round(m + rm) : m, delta = mn - m;
        const float f = (l == 0.f) ? 1.0f : __builtin_amdgcn_exp2f(-delta);
        l *= f;
        if (hi == 0) wsf[r32] = f;
        LDS_WAIT();
#pragma unroll
        for (int r = 0; r < 16; ++r) { const float fr = wsf[crow(r, hi)]; o[0][r] *= fr; o[1][r] *= fr; p0[r] -= delta; p1[r] -= delta; }
        LDS_WAIT();
        m = mn; qx = qx_frag(m, hi);
    }
    f32x16 e0, e1; float s0 = 0.f, s1 = 0.f;
#pragma unroll
    for (int r = 0; r < 16; ++r) { e0[r] = __builtin_amdgcn_exp2f(p0[r]); e1[r] = __builtin_amdgcn_exp2f(p1[r]); s0 += e0[r]; s1 += e1[r]; }
    l += s0 + s1;
    pack_p(e0, e1, pa);
}
__device__ __forceinline__ void softmax_fast(const f32x16& p0, const f32x16& p1, float& l, bf16x8 (&pa)[4]) {
    f32x16 e0, e1; float s0 = 0.f, s1 = 0.f;
#pragma unroll
    for (int r = 0; r < 16; ++r) { e0[r] = __builtin_amdgcn_exp2f(p0[r]); e1[r] = __builtin_amdgcn_exp2f(p1[r]); s0 += e0[r]; s1 += e1[r]; }
    l += s0 + s1;
    pack_p(e0, e1, pa);
}
__device__ __forceinline__ bool acc_in_range(float lsum, const f32x16 (&o)[2]) {
    bool ok = (lsum > 0.f) && (lsum < INFINITY);
#pragma unroll
    for (int r = 0; r < 16; ++r) ok = ok && (fabsf(o[0][r]) < INFINITY) && (fabsf(o[1][r]) < INFINITY);
    return ok;
}
__device__ __forceinline__ void stage_o(LAS float* stg, const f32x16 (&o)[2], const float (&rs)[16], int r32, int hi) {
#pragma unroll
    for (int r = 0; r < 16; ++r) { const int q = crow(r, hi); stg[q * 64 + r32] = o[0][r] * rs[r]; stg[q * 64 + 32 + r32] = o[1][r] * rs[r]; }
}
template <bool RMS>
__device__ __forceinline__ void store_o(const LAS float* stg, bf16_t* dst  , int lane, const float* gain, float outscale) {
    LDS_WAIT();
    const int ch = lane & 7;
    float g8[8];
#pragma unroll
    for (int j = 0; j < 8; ++j) g8[j] = RMS ? gain[ch * 8 + j] * outscale : 1.0f;
#pragma unroll
    for (int i = 0; i < 4; ++i) { const int row = i * 8 + (lane >> 3);
        const f32x4 a = *(const LAS f32x4*)(stg + row * 64 + ch * 8), b = *(const LAS f32x4*)(stg + row * 64 + ch * 8 + 4);
        float v[8] = {a.x, a.y, a.z, a.w, b.x, b.y, b.z, b.w};
        if (RMS) { float ss = 0.f;
#pragma unroll
            for (int j = 0; j < 8; ++j) ss += v[j] * v[j];
            ss += shflx(ss, 1, lane); ss += shflx(ss, 2, lane); ss += shflx(ss, 4, lane);
            const float rstd = 1.0f / sqrtf(ss * (1.0f / 64.0f) + NORM_EPS);
#pragma unroll
            for (int j = 0; j < 8; ++j) v[j] = v[j] * rstd * g8[j]; }
        u32x4 w; w.x = cvtpk(v[0], v[1]); w.y = cvtpk(v[2], v[3]); w.z = cvtpk(v[4], v[5]); w.w = cvtpk(v[6], v[7]);
        *(u32x4*)(dst + (size_t)row * DM + ch * 8) = w; }
    LDS_WAIT();
}
__device__ __forceinline__ void load_q(const Ctx& c, bf16x8* qf, long qrow, int col, int nd) {
    for (int d0 = 0; d0 < nd; ++d0) qf[d0] = *(const bf16x8*)(c.proj + (size_t)qrow * INC + col + d0 * 16 + c.hi * 8);
}

__device__ __forceinline__ float tile_rowmax(const f32x16& p0, const f32x16& p1) {
    float ra = max3f(p0[0], p1[0], p0[1]), rb = max3f(p0[4], p1[4], p0[5]), rc = max3f(p0[8], p1[8], p0[9]), rd = max3f(p0[12], p1[12], p0[13]);
    ra = max3f(ra, p1[1], p0[2]); rb = max3f(rb, p1[5], p0[6]); rc = max3f(rc, p1[9], p0[10]); rd = max3f(rd, p1[13], p0[14]);
    ra = max3f(ra, p1[2], p0[3]); rb = max3f(rb, p1[6], p0[7]); rc = max3f(rc, p1[10], p0[11]); rd = max3f(rd, p1[14], p0[15]);
    ra = max3f(ra, p1[3], rb); rc = max3f(rc, p1[7], rd);
    float rm = max3f(ra, rc, p1[11]); rm = max3f(rm, p1[15], p1[15]);
    return swapmax(rm);
}
__device__ __forceinline__ float tile_update(f32x16& p0, f32x16& p1, float rm, float& m, float& l, unsigned& qx, int hi) {
    const bool upd = (rm > 0.f) || (l == 0.f && rm > -INFINITY);
    const float mn = upd ? bf_round(m + rm) : m, delta = mn - m;
    const float f = (l == 0.f) ? 1.0f : __builtin_amdgcn_exp2f(-delta);
    l *= f;
#pragma unroll
    for (int r = 0; r < 16; ++r) { p0[r] -= delta; p1[r] -= delta; }
    m = mn; qx = qx_frag(m, hi);
    return f;
}
__device__ __forceinline__ void o_rescale(f32x16 (&o)[2], float f, LAS float* wsf, int r32, int hi) {
    if (hi == 0) wsf[r32] = f;
    LDS_WAIT();
#pragma unroll
    for (int r = 0; r < 16; ++r) { const float fr = wsf[crow(r, hi)]; o[0][r] *= fr; o[1][r] *= fr; }
    LDS_WAIT();
}
template <bool ODD>
__device__ __forceinline__ void pv_exp_map(f32x16 (&o)[2], ldsp vslot, bf16x8 (&P)[4], const f32x16& p0, const f32x16& p1, float& l, int lane, int hi) {
    ldsp vb = vslot + ((lane >> 4) & 1) * 32 + (lane & 3) * 8 + (4 * hi + ((lane & 15) >> 2)) * 64;
    float s0 = 0.f, s1 = 0.f; unsigned wa[4], wb[4];
#pragma unroll
    for (int ks = 0; ks < 4; ++ks) {
        const int slot = ODD ? ((ks == 1) ? 2 : (ks == 2) ? 1 : ks) : ks;
        const s16x4 l0 = vtr(vb + ks * 1024), h0 = vtr(vb + ks * 1024 + 512), l1 = vtr(vb + 4096 + ks * 1024), h1 = vtr(vb + 4096 + ks * 1024 + 512);
        const bf16x8 v0 = (bf16x8){l0[0], l0[1], l0[2], l0[3], h0[0], h0[1], h0[2], h0[3]}, v1 = (bf16x8){l1[0], l1[1], l1[2], l1[3], h1[0], h1[1], h1[2], h1[3]};
        o[0] = __builtin_amdgcn_mfma_f32_32x32x16_bf16(P[slot], v0, o[0], 0, 0, 0);
        o[1] = __builtin_amdgcn_mfma_f32_32x32x16_bf16(P[slot], v1, o[1], 0, 0, 0);
        const int g = 4 * ks;
        const float a0 = __builtin_amdgcn_exp2f(p0[g]), a1 = __builtin_amdgcn_exp2f(p0[g + 1]), a2 = __builtin_amdgcn_exp2f(p0[g + 2]), a3 = __builtin_amdgcn_exp2f(p0[g + 3]);
        const float b0 = __builtin_amdgcn_exp2f(p1[g]), b1 = __builtin_amdgcn_exp2f(p1[g + 1]), b2 = __builtin_amdgcn_exp2f(p1[g + 2]), b3 = __builtin_amdgcn_exp2f(p1[g + 3]);
        s0 += (a0 + a1) + (a2 + a3); s1 += (b0 + b1) + (b2 + b3);
        wa[2 * (ks & 1)] = cvtpk(a0, a1); wa[2 * (ks & 1) + 1] = cvtpk(a2, a3); wb[2 * (ks & 1)] = cvtpk(b0, b1); wb[2 * (ks & 1) + 1] = cvtpk(b2, b3);
        if (ks & 1) {
            const int sprev = ODD ? ((ks == 1) ? 0 : 1) : ks - 1;
            u32x4 qa, qb; qa.x = wa[0]; qa.y = wa[1]; qa.z = wa[2]; qa.w = wa[3]; qb.x = wb[0]; qb.y = wb[1]; qb.z = wb[2]; qb.w = wb[3];
            P[sprev] = __builtin_bit_cast(bf16x8, qa); P[slot] = __builtin_bit_cast(bf16x8, qb);
        }
    }
    l += s0 + s1;
}
#define DIFF_PFR(P, ODD_, k) ((ODD_) ? P[((k) == 1) ? 2 : ((k) == 2) ? 1 : (k)] : P[(k)])
template <bool SAFE>
__device__ __forceinline__ void diff_core(const Ctx& c, long rowbase, int h, int qb, ldsp qlds, float& l1, float& l2, f32x16 (&o1)[2], f32x16 (&o2)[2]) {
    const int q0 = qb * 256, qmin = q0 + 32 * c.wid, qabs = qmin + c.r32;
#define DIFF_QK(NX) do { bf16x8 qa_[2], qb_[2]; qa_[0] = *(const LAS bf16x8*)(qlds); qa_[1] = *(const LAS bf16x8*)(qlds + 16); qb_[0] = *(const LAS bf16x8*)(qlds + 32); qb_[1] = *(const LAS bf16x8*)(qlds + 48); \
        qk_tile<2, SAFE>(sa0, sa1, (NX), qa_, c.r32, c.hi, qx1); qk_tile<2, SAFE>(sb0, sb1, (NX) + 4096, qb_, c.r32, c.hi, qx2); } while (0)
    float m1 = 0.f, m2 = 0.f; unsigned qx1 = 0u, qx2 = 0u; l1 = 0.f; l2 = 0.f; o1[0] = (f32x16){}; o1[1] = (f32x16){}; o2[0] = (f32x16){}; o2[1] = (f32x16){};
    LAS float* wsf = (LAS float*)(c.lds + A_WSF) + c.wid * 64; const LAS float* tab = (const LAS float*)(c.lds + A_TAB) + (4 + h) * 128;
    const int NT = 4 * (qb + 1);
    const KVB kvb = kv_base<true>(c, rowbase, CB_K1 + h * 32, CB_K2 + h * 32, CB_V + h * 64);
    VM_WAIT();
#pragma unroll
    for (int j = 0; j < 4; ++j) stage_kvb(c, j, kvb, 64 * j);
    WAIT_BAR(0);
    f32x16 sa0, sa1, sb0, sb1; bf16x8 P1[4], P2[4];
#pragma unroll
    for (int i = 0; i < 4; ++i) { P1[i] = bf16x8{}; P2[i] = bf16x8{}; }
    DIFF_QK(c.lds + A_KV);
    int sl = 0;
#define DIFF_MAP(ODD_, S0, S1, M_, L_, QX_, O_, P_, DB_) do { \
        if (act && (causal || lookup)) mask_bias(S0, S1, DB_, c.hi, tab, lookup, 113, causal, false, false); \
        if (SAFE) { const float rm = tile_rowmax(S0, S1); float f = 1.0f; const bool u = __any((rm > 0.f) || (L_ == 0.f && rm > -INFINITY)) != 0; \
            if (u) f = tile_update(S0, S1, rm, M_, L_, QX_, c.hi); \
            pv_exp_map<ODD_>(O_, vprev, P_, S0, S1, L_, c.lane, c.hi); \
            if (u) o_rescale(O_, f, wsf, c.r32, c.hi); } \
        else pv_exp_map<ODD_>(O_, vprev, P_, S0, S1, L_, c.lane, c.hi); } while (0)
#define DIFF_ITER(t, ODD_) do { \
        const int k0 = 64 * (t); const bool act = (k0 <= qmin + 31), actp = ((t) == 0) || (k0 - 64 <= qmin + 31); \
        if ((t) + 4 < NT) stage_kvb(c, sl >= 2 ? sl - 2 : sl + 4, kvb, 64 * ((t) + 4)); \
        const int slp = ((t) == 0) ? 0 : (sl == 0 ? 5 : sl - 1), sln = sl == 5 ? 0 : sl + 1; \
        ldsp vprev = c.lds + A_KV + slp * 16384 + 8192; \
        if (actp) {     \
            const bool causal = (k0 + 63 > qmin), lookup = act && (qmin - (k0 + 63) < 113); \
            if (!act) { _Pragma("unroll") for (int r_ = 0; r_ < 16; ++r_) { sa0[r_] = -INFINITY; sa1[r_] = -INFINITY; sb0[r_] = -INFINITY; sb1[r_] = -INFINITY; } } \
            DIFF_MAP(ODD_, sa0, sa1, m1, l1, qx1, o1, P1, qabs - k0); \
            { int db2 = qabs - k0; asm volatile("" : "+v"(db2)); DIFF_MAP(ODD_, sb0, sb1, m2, l2, qx2, o2, P2, db2); } \
        } \
        if ((t) + 1 < NT && k0 + 64 <= qmin + 31) { ldsp nx = c.lds + A_KV + sln * 16384; DIFF_QK(nx); } \
        if ((t) + 4 < NT) WAIT_BAR(4); else if ((t) + 3 < NT) WAIT_BAR(2); else WAIT_BAR(0); \
        sl = sln; } while (0)
#pragma unroll 1
    for (int t = 0; t < NT; t += 2) {
        DIFF_ITER(t, false);
        DIFF_ITER(t + 1, true);
    }
#undef DIFF_ITER
#undef DIFF_MAP
#undef DIFF_QK
    if (64 * (NT - 1) <= qmin + 31) pv_tile<2>(o1, o2, c.lds + A_KV + (sl == 0 ? 5 : sl - 1) * 16384 + 8192, P1, P2, c.lane, c.hi);
    BAR_L();
}
struct DFrag { s16x4 l0, h0, l1, h1; bf16x8 kf; };
template <int KS>
__device__ __forceinline__ void diff_read(DFrag& f, ldsp vb, ldsp kb) {
    f.l0 = vtr(vb + KS * 1024); f.h0 = vtr(vb + KS * 1024 + 512); f.l1 = vtr(vb + 4096 + KS * 1024); f.h1 = vtr(vb + 4096 + KS * 1024 + 512);
    f.kf = *(const LAS bf16x8*)(kb + (KS >> 1) * 2048 + (KS & 1) * 512);
}
template <int KS, bool NEXT>
__device__ __forceinline__ void diff_step(f32x16 (&o)[2], bf16x8 (&P)[4], const f32x16& s0, const f32x16& s1, float& l, f32x16& n0, f32x16& n1, const bf16x8 (&qf)[2], const DFrag& cur, DFrag& nxt, ldsp vbn, ldsp kbn) {
    constexpr int g = 8 * (KS & 1);
    const f32x16& src = (KS < 2) ? s0 : s1;
    if (NEXT) diff_read<(KS + 1) & 3>(nxt, vbn, kbn);
    const bf16x8 v0 = (bf16x8){cur.l0[0], cur.l0[1], cur.l0[2], cur.l0[3], cur.h0[0], cur.h0[1], cur.h0[2], cur.h0[3]}, v1 = (bf16x8){cur.l1[0], cur.l1[1], cur.l1[2], cur.l1[3], cur.h1[0], cur.h1[1], cur.h1[2], cur.h1[3]};
    o[0] = __builtin_amdgcn_mfma_f32_32x32x16_bf16(P[KS], v0, o[0], 0, 0, 0);
    __builtin_amdgcn_sched_barrier(0);
    float e0 = __builtin_amdgcn_exp2f(src[g]), e1 = __builtin_amdgcn_exp2f(src[g + 1]), e2 = __builtin_amdgcn_exp2f(src[g + 2]), e3 = __builtin_amdgcn_exp2f(src[g + 3]);
    asm volatile("" : "+v"(e0), "+v"(e1), "+v"(e2), "+v"(e3));
    __builtin_amdgcn_sched_barrier(0);
    o[1] = __builtin_amdgcn_mfma_f32_32x32x16_bf16(P[KS], v1, o[1], 0, 0, 0);
    __builtin_amdgcn_sched_barrier(0);
    float c0 = e0 + e1; c0 += e2; c0 += e3;
    float e4 = __builtin_amdgcn_exp2f(src[g + 4]), e5 = __builtin_amdgcn_exp2f(src[g + 5]), e6 = __builtin_amdgcn_exp2f(src[g + 6]), e7 = __builtin_amdgcn_exp2f(src[g + 7]);
    u32x4 w; w.x = cvtpk(e0, e1); w.y = cvtpk(e2, e3);
    asm volatile("" : "+v"(e4), "+v"(e5), "+v"(e6), "+v"(e7), "+v"(w.x), "+v"(w.y), "+v"(c0));
    __builtin_amdgcn_sched_barrier(0);
    if ((KS & 1) == 0) n0 = __builtin_amdgcn_mfma_f32_32x32x16_bf16(cur.kf, qf[KS >> 1], (KS < 2) ? (f32x16){} : n0, 0, 0, 0);
    else               n1 = __builtin_amdgcn_mfma_f32_32x32x16_bf16(cur.kf, qf[KS >> 1], (KS < 2) ? (f32x16){} : n1, 0, 0, 0);
    __builtin_amdgcn_sched_barrier(0);
    float c1 = e4 + e5; c1 += e6; c1 += e7;
    w.z = cvtpk(e4, e5); w.w = cvtpk(e6, e7);
    l += c0; l += c1;
    P[KS] = __builtin_bit_cast(bf16x8, w);
    asm volatile("" : "+v"(P[KS]), "+v"(l));
    __builtin_amdgcn_sched_barrier(0);
}
__device__ __forceinline__ void diff_fast(const Ctx& c, long rowbase, int h, int qb_, ldsp qlds, float& l1, float& l2, f32x16 (&o1)[2], f32x16 (&o2)[2]) {
    const int qb = __builtin_amdgcn_readfirstlane(qb_);
    const int q0 = qb * 256, qmin = __builtin_amdgcn_readfirstlane(q0 + 32 * c.wid), qabs = qmin + c.r32;
    l1 = 0.f; l2 = 0.f; o1[0] = (f32x16){}; o1[1] = (f32x16){}; o2[0] = (f32x16){}; o2[1] = (f32x16){};
    const LAS float* tab = (const LAS float*)(c.lds + A_TAB) + (4 + h) * 128;
    const int NT = 4 * (qb + 1);
    const KVB kvb = kv_base<true>(c, rowbase, CB_K1 + h * 32, CB_K2 + h * 32, CB_V + h * 64);
    VM_WAIT();
#pragma unroll
    for (int j = 0; j < 3; ++j) stage_kvb(c, j, kvb, 64 * j);
    WAIT_BAR(0);
    f32x16 sa0, sa1, sb0, sb1; bf16x8 P1[4], P2[4];
#pragma unroll
    for (int i = 0; i < 4; ++i) { P1[i] = bf16x8{}; P2[i] = bf16x8{}; }
    { bf16x8 qa_[2]; qa_[0] = *(const LAS bf16x8*)(qlds); qa_[1] = *(const LAS bf16x8*)(qlds + 16); qk_tile<2, false>(sa0, sa1, c.lds + A_KV, qa_, c.r32, c.hi); }
#define DIFF_TILE(T_, SLP_, SL_, SLN_) do { \
        const int k0 = 64 * (T_); const bool act = (k0 <= qmin + 31), actp = ((T_) == 0) || (k0 - 64 <= qmin + 31); \
        if (actp) {     \
            ldsp vb = c.lds + A_KV + (SLP_) * 16384 + 8192 + ((c.lane >> 4) & 1) * 32 + (c.lane & 3) * 8 + (4 * c.hi + ((c.lane & 15) >> 2)) * 64; \
            ldsp kb2 = c.lds + A_KV + (SL_) * 16384 + 4096 + c.hi * 1024 + c.r32 * 16, kb1 = c.lds + A_KV + (SLN_) * 16384 + c.hi * 1024 + c.r32 * 16; \
            DFrag f0, f1; \
            diff_read<0>(f0, vb, kb2); \
            const bool causal = (k0 + 63 > qmin), lookup = act && (qmin - (k0 + 63) < 113); \
            if (!act) { \
                _Pragma("unroll") for (int r_ = 0; r_ < 16; ++r_) { sa0[r_] = -INFINITY; sa1[r_] = -INFINITY; } \
            } else if (causal || lookup) mask_bias(sa0, sa1, qabs - k0, c.hi, tab, lookup, 113, causal, false, false); \
            { bf16x8 qb_[2]; qb_[0] = *(const LAS bf16x8*)(qlds + 32); qb_[1] = *(const LAS bf16x8*)(qlds + 48); \
              diff_step<0, true>(o1, P1, sa0, sa1, l1, sb0, sb1, qb_, f0, f1, vb, kb2); diff_step<1, true>(o1, P1, sa0, sa1, l1, sb0, sb1, qb_, f1, f0, vb, kb2); \
              diff_step<2, true>(o1, P1, sa0, sa1, l1, sb0, sb1, qb_, f0, f1, vb, kb2); diff_step<3, true>(o1, P1, sa0, sa1, l1, sb0, sb1, qb_, f1, f0, vb, kb1); } \
            if (!act) { \
                _Pragma("unroll") for (int r_ = 0; r_ < 16; ++r_) { sb0[r_] = -INFINITY; sb1[r_] = -INFINITY; } \
            } else if (causal || lookup) { int db2 = qabs - k0; asm volatile("" : "+v"(db2)); mask_bias(sb0, sb1, db2, c.hi, tab, lookup, 113, causal, false, false); } \
            { bf16x8 qa_[2]; qa_[0] = *(const LAS bf16x8*)(qlds); qa_[1] = *(const LAS bf16x8*)(qlds + 16); \
              diff_step<0, true>(o2, P2, sb0, sb1, l2, sa0, sa1, qa_, f0, f1, vb, kb1); diff_step<1, true>(o2, P2, sb0, sb1, l2, sa0, sa1, qa_, f1, f0, vb, kb1); \
              diff_step<2, true>(o2, P2, sb0, sb1, l2, sa0, sa1, qa_, f0, f1, vb, kb1); diff_step<3, false>(o2, P2, sb0, sb1, l2, sa0, sa1, qa_, f1, f0, vb, kb1); } \
        } } while (0)
    int sl = 0;
#pragma unroll 1
    for (int t = 0; t < NT; t += 2) {
        const int s2 = sl == 4 ? 0 : sl + 2, s3 = sl >= 3 ? sl - 3 : sl + 3, s4 = sl >= 2 ? sl - 2 : sl + 4, sm1 = sl == 0 ? 5 : sl - 1;
        if (t + 3 < NT) stage_kvb(c, s3, kvb, 64 * (t + 3));
        if (t + 4 < NT) stage_kvb(c, s4, kvb, 64 * (t + 4));
        DIFF_TILE(t, (t == 0 ? 0 : sm1), sl, sl + 1);
        DIFF_TILE(t + 1, sl, sl + 1, s2);
        WAIT_BAR(0);
        sl = s2;
    }
#undef DIFF_TILE
    if (64 * (NT - 1) <= qmin + 31) pv_tile<2>(o1, o2, c.lds + A_KV + (sl == 0 ? 5 : sl - 1) * 16384 + 8192, P1, P2, c.lane, c.hi);
    BAR_L();
}
__device__ __forceinline__ void diff_unit(const Ctx& c, int b, int h, int qb, float lam, const float* subln, float outscale) {
    const long rowbase = (long)b * SEQ; const int q0 = qb * 256, qmin = q0 + 32 * c.wid, qabs = qmin + c.r32;
    LAS unsigned* misc = (LAS unsigned*)(c.lds + A_MISC);
    if (c.tid == 0) misc[2] = 0u;
    {
        bf16x8 q1f[2], q2f[2];
#pragma unroll
        for (int d0 = 0; d0 < 2; ++d0) { q1f[d0] = *(const bf16x8*)(c.proj + (size_t)(rowbase + qabs) * INC + CB_Q1 + h * 32 + d0 * 16 + c.hi * 8); q2f[d0] = *(const bf16x8*)(c.proj + (size_t)(rowbase + qabs) * INC + CB_Q2 + h * 32 + d0 * 16 + c.hi * 8); }
        ldsp ql = c.lds + A_OST + 32768 + c.wid * 4096 + c.lane * 64;
        *(LAS bf16x8*)(ql) = q1f[0]; *(LAS bf16x8*)(ql + 16) = q1f[1]; *(LAS bf16x8*)(ql + 32) = q2f[0]; *(LAS bf16x8*)(ql + 48) = q2f[1];
        asm volatile("s_waitcnt vmcnt(0) lgkmcnt(0)" ::: "memory");
    }
    ldsp qlds = c.lds + A_OST + 32768 + c.wid * 4096 + c.lane * 64;
    float l1, l2; f32x16 o1[2], o2[2];
    diff_fast(c, rowbase, h, qb, qlds, l1, l2, o1, o2);
    l1 = swapsum(l1); l2 = swapsum(l2);
    {
        bool ok = (l1 > 0.f) && (l1 < INFINITY) && (l2 > 0.f) && (l2 < INFINITY);
#pragma unroll
        for (int r = 0; r < 16; ++r) ok = ok && (fabsf(o1[0][r]) < INFINITY) && (fabsf(o1[1][r]) < INFINITY) && (fabsf(o2[0][r]) < INFINITY) && (fabsf(o2[1][r]) < INFINITY);
        if (__any(!ok) && c.lane == 0) __hip_atomic_fetch_or(misc + 2, 1u, __ATOMIC_RELAXED, __HIP_MEMORY_SCOPE_WORKGROUP);
    }
    BAR_L();
    if (misc[2] != 0u) {
        diff_core<true>(c, rowbase, h, qb, qlds, l1, l2, o1, o2);
        l1 = swapsum(l1); l2 = swapsum(l2);
    }
    LAS float* wsf = (LAS float*)(c.lds + A_WSF) + c.wid * 64;
    if (c.hi == 0) { wsf[c.r32] = 1.0f / l1; wsf[32 + c.r32] = lam / l2; }
    LDS_WAIT();
    f32x16 od[2]; float one[16];
#pragma unroll
    for (int r = 0; r < 16; ++r) { const int q = crow(r, c.hi); const float a = wsf[q], bb = wsf[32 + q]; od[0][r] = o1[0][r] * a - o2[0][r] * bb; od[1][r] = o1[1][r] * a - o2[1][r] * bb; one[r] = 1.0f; }
    LAS float* stg = (LAS float*)(c.lds + A_OST + c.wid * 8192);
    stage_o(stg, od, one, c.r32, c.hi);
    store_o<true>(stg, c.o + (size_t)(rowbase + qmin) * DM + 256 + h * 64, c.lane, subln, outscale);
}

__device__ __forceinline__ void moba_select_unit(const Ctx& c, int b, int h, int qb, const float* kmsum, unsigned* mcnt, unsigned* mlist) {
    const long rowbase = (long)b * SEQ; const int q0 = qb * 256, qabs = q0 + 32 * c.wid + c.r32, bh = b * 4 + h;
    LAS float* km = (LAS float*)(c.lds + A_KM);
    for (int idx = c.tid; idx < qb * 64; idx += 512) km[idx] = __hip_atomic_load(kmsum + (size_t)(b * 32 + (idx >> 6)) * 256 + h * 64 + (idx & 63), __ATOMIC_RELAXED, __HIP_MEMORY_SCOPE_AGENT);
    __syncthreads();
    float qv[64];
#pragma unroll
    for (int j = 0; j < 8; ++j) { const u32x4 w = *(const u32x4*)(c.proj + (size_t)(rowbase + qabs) * INC + CA_Q + h * 64 + j * 8);
        qv[8 * j + 0] = bf_lo(w.x); qv[8 * j + 1] = bf_hi(w.x); qv[8 * j + 2] = bf_lo(w.y); qv[8 * j + 3] = bf_hi(w.y); qv[8 * j + 4] = bf_lo(w.z); qv[8 * j + 5] = bf_hi(w.z); qv[8 * j + 6] = bf_lo(w.w); qv[8 * j + 7] = bf_hi(w.w); }
    float v0 = -INFINITY, v1 = -INFINITY, v2 = -INFINITY; int i0 = 64, i1 = 64, i2 = 64;
#define MOBA_INS(g, n) do { const float g_ = (g); const int n_ = (n); \
    if (g_ > v0 || (g_ == v0 && n_ < i0)) { v2 = v1; i2 = i1; v1 = v0; i1 = i0; v0 = g_; i0 = n_; } \
    else if (g_ > v1 || (g_ == v1 && n_ < i1)) { v2 = v1; i2 = i1; v1 = g_; i1 = n_; } \
    else if (g_ > v2 || (g_ == v2 && n_ < i2)) { v2 = g_; i2 = n_; } } while (0)
    for (int nn = 0; 2 * nn < qb; ++nn) {
        const int n = 2 * nn + c.hi;
        if (n < qb) { float g = 0.f;
#pragma unroll
            for (int d4 = 0; d4 < 16; ++d4) { const f32x4 k4 = *(const LAS f32x4*)(km + n * 64 + 4 * d4); g += (qv[4 * d4] * k4.x + qv[4 * d4 + 1] * k4.y) + (qv[4 * d4 + 2] * k4.z + qv[4 * d4 + 3] * k4.w); }
            MOBA_INS(g, n); }
    }
    const float pv0 = shflx(v0, 32, c.lane), pv1 = shflx(v1, 32, c.lane), pv2 = shflx(v2, 32, c.lane); const int pi0 = shflxi(i0, 32, c.lane), pi1 = shflxi(i1, 32, c.lane), pi2 = shflxi(i2, 32, c.lane);
    if (pi0 < 64) MOBA_INS(pv0, pi0);
    if (pi1 < 64) MOBA_INS(pv1, pi1);
    if (pi2 < 64) MOBA_INS(pv2, pi2);
#undef MOBA_INS
    if (c.hi == 0) {
        const int sel[3] = {i0, i1, i2};
#pragma unroll
        for (int j = 0; j < 3; ++j) if (sel[j] < 64) {
            const unsigned pos = __hip_atomic_fetch_add(mcnt + (size_t)(bh * 32 + sel[j]) * 64, 1u, __ATOMIC_RELAXED, __HIP_MEMORY_SCOPE_AGENT);
            mlist[(size_t)(bh * 32 + sel[j]) * 8192 + pos] = (unsigned)qabs | ((unsigned)j << 16);
        }
    }
}
__device__ __forceinline__ void store_part(const Ctx& c, const LAS float* stg, unsigned entry, float m, float l, int bh, bf16_t* po, float* pml) {
    LAS unsigned* ent = (LAS unsigned*)(c.lds + A_MISC) + 64 + c.wid * 32;
    if (c.hi == 0) { ent[c.r32] = entry;
        if (entry != 0xffffffffu) { f32x2_t v = {m, l}; *(f32x2_t*)(pml + ((size_t)(bh * 8192 + (entry & 0xffffu)) * 4 + (entry >> 16)) * 2) = v; } }
    LDS_WAIT();
    const int ch = c.lane & 7;
#pragma unroll
    for (int i = 0; i < 4; ++i) { const int row = i * 8 + (c.lane >> 3); const unsigned e = ent[row];
        const f32x4 a = *(const LAS f32x4*)(stg + row * 64 + ch * 8), b = *(const LAS f32x4*)(stg + row * 64 + ch * 8 + 4);
        u32x4 w; w.x = cvtpk(a.x, a.y); w.y = cvtpk(a.z, a.w); w.z = cvtpk(b.x, b.y); w.w = cvtpk(b.z, b.w);
        if (e != 0xffffffffu) *(u32x4*)(po + ((size_t)(bh * 8192 + (e & 0xffffu)) * 4 + (e >> 16)) * 64 + ch * 8) = w; }
    LDS_WAIT();
}
struct MUnit { int bh, n, chunk, cnt, sparse; };
__device__ __forceinline__ MUnit moba_desc(int u, int nsp_w, int bid, int G, const LAS int* pre, const LAS int* lcnt) {
    MUnit U;
    if (u < nsp_w) { const int item = bid + u * G; int lo_ = 0, hi_ = 511; while (lo_ < hi_) { const int mid = (lo_ + hi_) >> 1; if (pre[mid] > item) hi_ = mid; else lo_ = mid + 1; }
        const int li = __builtin_amdgcn_readfirstlane(lo_); U.chunk = item - (li > 0 ? __builtin_amdgcn_readfirstlane(pre[li > 0 ? li - 1 : 0]) : 0); U.cnt = __builtin_amdgcn_readfirstlane(lcnt[li]); U.bh = li >> 5; U.n = li & 31; U.sparse = 1; }
    else { const int item = __builtin_amdgcn_readfirstlane(bid + (u - nsp_w) * G); U.n = 31 - (item >> 4); U.bh = item & 15; U.chunk = 0; U.cnt = 256; U.sparse = 0; }
    return U;
}
__device__ __forceinline__ unsigned moba_entry_raw(const Ctx& c, const MUnit& U, const unsigned* mlist) {
    if (U.sparse) { const int ridx = U.chunk * 256 + 32 * c.wid + c.r32; return mlist[(size_t)(U.bh * 32 + U.n) * 8192 + (ridx < U.cnt ? ridx : 0)]; }
    return (unsigned)(U.n * 256 + 32 * c.wid + c.r32) | (3u << 16);
}
__device__ __forceinline__ void moba_stage(const Ctx& c, const MUnit& U) {
    const KVB kvb = kv_base<false>(c, (long)(U.bh >> 2) * SEQ, CA_K + (U.bh & 3) * 64, 0, CA_V + (U.bh & 3) * 64);
#pragma unroll
    for (int j = 0; j < 4; ++j) stage_kvb(c, j, kvb, U.n * 256 + 64 * j);
}
__device__ __forceinline__ void moba_loadq(const Ctx& c, const MUnit& U, unsigned eraw, bf16x8 (&qf)[4]) {
    const int t = (int)(eraw & 0xffffu); const long rowbase = (long)(U.bh >> 2) * SEQ;
#pragma unroll
    for (int d0 = 0; d0 < 4; ++d0) qf[d0] = *(const bf16x8*)(c.proj + (size_t)(rowbase + t) * INC + CA_Q + (U.bh & 3) * 64 + d0 * 16 + c.hi * 8);
}
__device__ __forceinline__ void moba_units(const Ctx& c, int bid, int G, int NSP, const LAS int* pre, const LAS int* lcnt, const unsigned* mlist, bf16_t* po, float* pml) {
    const int nsp_w = (NSP > bid) ? (NSP - bid + G - 1) / G : 0, nown_w = (512 > bid) ? (512 - bid + G - 1) / G : 0, NU = nsp_w + nown_w;
    if (NU == 0) return;
    MUnit U = moba_desc(0, nsp_w, bid, G, pre, lcnt);
    __syncthreads();
    moba_stage(c, U);
    unsigned eraw = moba_entry_raw(c, U, mlist);
    bf16x8 qf[4];
    moba_loadq(c, U, eraw, qf);
#pragma unroll 1
    for (int u = 0; u < NU; ++u) {
        asm volatile("" : "+v"(qf[0]), "+v"(qf[1]), "+v"(qf[2]), "+v"(qf[3]));
        WAIT_BAR(0);
        const bool more = (u + 1 < NU);
        MUnit Un = U; unsigned en = 0u;
        if (more) { Un = moba_desc(u + 1, nsp_w, bid, G, pre, lcnt); en = moba_entry_raw(c, Un, mlist); }
        const int h = U.bh & 3, n = U.n; const bool SPARSE = U.sparse != 0;
        const int ridx = U.chunk * 256 + 32 * c.wid + c.r32; const int t = (int)(eraw & 0xffffu);
        const unsigned entry = (!SPARSE || ridx < U.cnt) ? eraw : 0xffffffffu;
        float m = 0.f, l = 0.f; unsigned qx = 0u; f32x16 o[2]; o[0] = (f32x16){}; o[1] = (f32x16){};
        LAS float* wsf = (LAS float*)(c.lds + A_WSF) + c.wid * 64; const LAS float* tab = (const LAS float*)(c.lds + A_TAB) + h * 128;
        const int wmin = n * 256 + 32 * c.wid;
#define MOBA_TILES(SAFE_) _Pragma("unroll 1") for (int j = 0; j < 4; ++j) { \
        const int k0 = n * 256 + 64 * j; \
        if (!SPARSE && k0 > wmin + 31) break; \
        ldsp cur = c.lds + A_KV + j * 16384; \
        f32x16 p0, p1; bf16x8 pa[4]; \
        qk_tile<4, SAFE_>(p0, p1, cur, qf, c.r32, c.hi, qx); \
        const int dbase = t - k0; \
        const bool causal = !SPARSE && (k0 + 63 > wmin), lookup = __any(dbase - 63 < 113) != 0; \
        if (lookup || causal) mask_bias(p0, p1, dbase, c.hi, tab, lookup, 113, causal, false, false); \
        if (SAFE_) softmax_tile(p0, p1, m, l, o, wsf, c.r32, c.hi, pa, qx); else softmax_fast(p0, p1, l, pa); \
        pv_tile<1>(o, o, cur + 8192, pa, pa, c.lane, c.hi); }
        MOBA_TILES(false)
        if (__any(!acc_in_range(swapsum(l), o))) { m = 0.f; l = 0.f; qx = 0u; o[0] = (f32x16){}; o[1] = (f32x16){}; MOBA_TILES(true) }
#undef MOBA_TILES
        BAR_L();
        if (more) { moba_stage(c, Un); moba_loadq(c, Un, en, qf); }
        l = swapsum(l);
        if (c.hi == 0) wsf[c.r32] = 1.0f / l;
        LDS_WAIT();
        float rs[16];
#pragma unroll
        for (int r = 0; r < 16; ++r) rs[r] = wsf[crow(r, c.hi)];
        LAS float* stg = (LAS float*)(c.lds + A_OST + c.wid * 8192);
        stage_o(stg, o, rs, c.r32, c.hi);
        LDS_WAIT();
        store_part(c, stg, entry, m, l, U.bh, po, pml);
        U = Un; eraw = en;
    }
}
__device__ __forceinline__ void moba_combine(const Frame& F, const bf16_t* po, const float* pml, bf16_t* o) {
    const int gt = F.bid * 512 + F.tid, NT_ = F.G * 512;
    f32x2_t ml1[4]; u32x4 pv1[4];
#define COMB_ISSUE(idx_) do { const int ch_ = (idx_) & 7, hh_ = ((idx_) >> 3) & 3, row_ = (idx_) >> 5, bh_ = (row_ >> 13) * 4 + hh_; const size_t base_ = (size_t)(bh_ * 8192 + (row_ & 8191)) * 4; \
        _Pragma("unroll") for (int j = 0; j < 4; ++j) { ml1[j] = *(const f32x2_t*)(pml + (base_ + j) * 2); pv1[j] = *(const u32x4*)(po + (base_ + j) * 64 + ch_ * 8); } } while (0)
    if (gt < NTOK * 32) COMB_ISSUE(gt);
    for (int idx = gt; idx < NTOK * 32; idx += NT_) {
        const int ch = idx & 7, hh = (idx >> 3) & 3, row = idx >> 5, t = row & 8191, nsel = (t >> 8) < 3 ? (t >> 8) : 3;
        f32x2_t ml[4]; u32x4 pv[4];
#pragma unroll
        for (int j = 0; j < 4; ++j) { ml[j] = ml1[j]; pv[j] = pv1[j]; }
        if (idx + NT_ < NTOK * 32) COMB_ISSUE(idx + NT_);
        float M = -INFINITY;
#pragma unroll
        for (int j = 0; j < 4; ++j) { const bool on = (j == 3) || (j < nsel); M = on ? fmaxf(M, ml[j].x) : M; }
        float acc[8] = {0.f, 0.f, 0.f, 0.f, 0.f, 0.f, 0.f, 0.f}; float ws = 0.f;
#pragma unroll
        for (int j = 0; j < 4; ++j) { const bool on = (j == 3) || (j < nsel);
            const float w = on ? ml[j].y * __builtin_amdgcn_exp2f(ml[j].x - M) : 0.f; ws += w;
            u32x4 v = pv[j]; if (!on) v = (u32x4){0u, 0u, 0u, 0u};
            acc[0] += w * bf_lo(v.x); acc[1] += w * bf_hi(v.x); acc[2] += w * bf_lo(v.y); acc[3] += w * bf_hi(v.y); acc[4] += w * bf_lo(v.z); acc[5] += w * bf_hi(v.z); acc[6] += w * bf_lo(v.w); acc[7] += w * bf_hi(v.w); }
        const float inv = 1.0f / ws;
        u32x4 w; w.x = cvtpk(acc[0] * inv, acc[1] * inv); w.y = cvtpk(acc[2] * inv, acc[3] * inv); w.z = cvtpk(acc[4] * inv, acc[5] * inv); w.w = cvtpk(acc[6] * inv, acc[7] * inv);
        *(u32x4*)(o + (size_t)row * DM + hh * 64 + ch * 8) = w;
    }
#undef COMB_ISSUE
}

template <bool SAFE>
__device__ __forceinline__ void swa_core(const Ctx& c, long rowbase, int hq, int qb, float sink, const bf16x8 (&qf)[4], float& m, float& l, f32x16 (&o)[2]) {
    const int q0 = qb * 256, qmin = q0 + 32 * c.wid, qabs = qmin + c.r32, kvh = hq >> 1;
    unsigned qx = 0u;
    if (SAFE) { m = bf_round(sink * LOG2E); l = (c.hi == 0) ? __builtin_amdgcn_exp2f(sink * LOG2E - m) : 0.0f; qx = qx_frag(m, c.hi); }
    else { m = 0.f; l = (c.hi == 0) ? __builtin_amdgcn_exp2f(sink * LOG2E) : 0.0f; }
    o[0] = (f32x16){}; o[1] = (f32x16){};
    LAS float* wsf = (LAS float*)(c.lds + A_WSF) + c.wid * 64; const LAS float* tab = (const LAS float*)(c.lds + A_TAB) + (8 + hq) * 128;
    const int kstart = q0 >= 128 ? q0 - 128 : 0, NT = (q0 + 256 - kstart) / 64;
    VM_WAIT();
    const KVB kvb = kv_base<false>(c, rowbase, CD_K + kvh * 64, 0, CD_V + kvh * 64);
    stage_kvb(c, 0, kvb, kstart);
    stage_kvb(c, 1, kvb, kstart + 64);
    WAIT_BAR(2);
    int sl = 0;
    for (int t = 0; t < NT; ++t) {
        ldsp cur = c.lds + A_KV + sl * 16384;
        if (t + 2 < NT) stage_kvb(c, sl >= 1 ? sl - 1 : 2, kvb, kstart + 64 * (t + 2));
        const int k0 = kstart + 64 * t;
        if (k0 <= qmin + 31 && k0 + 63 >= qmin - 127) {
            f32x16 p0, p1; bf16x8 pa[4];
            qk_tile<4, SAFE>(p0, p1, cur, qf, c.r32, c.hi, qx);
            mask_bias(p0, p1, qabs - k0, c.hi, tab, true, 127, true, true, false);
            if (SAFE) softmax_tile(p0, p1, m, l, o, wsf, c.r32, c.hi, pa, qx); else softmax_fast(p0, p1, l, pa);
            pv_tile<1>(o, o, cur + 8192, pa, pa, c.lane, c.hi);
        }
        if (t + 2 < NT) WAIT_BAR(2); else WAIT_BAR(0);
        sl = sl == 2 ? 0 : sl + 1;
    }
}
__device__ __forceinline__ void swa_unit(const Ctx& c, int b, int hq, int qb, float sink) {
    const long rowbase = (long)b * SEQ; const int q0 = qb * 256, qmin = q0 + 32 * c.wid, qabs = qmin + c.r32;
    LAS unsigned* misc = (LAS unsigned*)(c.lds + A_MISC);
    if (c.tid == 0) misc[2] = 0u;
    bf16x8 qf[4];
#pragma unroll
    for (int d0 = 0; d0 < 4; ++d0) qf[d0] = *(const bf16x8*)(c.proj + (size_t)(rowbase + qabs) * INC + CD_Q + hq * 64 + d0 * 16 + c.hi * 8);
    asm volatile("" : "+v"(qf[0]), "+v"(qf[1]), "+v"(qf[2]), "+v"(qf[3]));
    float m, l; f32x16 o[2];
    swa_core<false>(c, rowbase, hq, qb, sink, qf, m, l, o);
    l = swapsum(l);
    if (__any(!acc_in_range(l, o)) && c.lane == 0) __hip_atomic_fetch_or(misc + 2, 1u, __ATOMIC_RELAXED, __HIP_MEMORY_SCOPE_WORKGROUP);
    BAR_L();
    if (misc[2] != 0u) { swa_core<true>(c, rowbase, hq, qb, sink, qf, m, l, o); l = swapsum(l); }
    LAS float* wsf = (LAS float*)(c.lds + A_WSF) + c.wid * 64;
    if (c.hi == 0) wsf[c.r32] = 1.0f / l;
    LDS_WAIT();
    float rs[16];
#pragma unroll
    for (int r = 0; r < 16; ++r) rs[r] = wsf[crow(r, c.hi)];
    LAS float* stg = (LAS float*)(c.lds + A_OST + c.wid * 8192);
    stage_o(stg, o, rs, c.r32, c.hi);
    store_o<false>(stg, c.o + (size_t)(rowbase + qmin) * DM + 768 + hq * 64, c.lane, nullptr, 1.0f);
}

__device__ __forceinline__ void sb_unit(const Ctx& c, int b, int h, int qb) {
    const long rowbase = (long)b * SEQ; const int q0 = qb * 256, qmin = q0 + 32 * c.wid, qabs = qmin + c.r32;
    LAS unsigned* misc = (LAS unsigned*)(c.lds + A_MISC);
    if (c.tid < 4) misc[16 + c.tid] = 0u;
    bf16x8 qf[4];
#pragma unroll
    for (int d0 = 0; d0 < 4; ++d0) qf[d0] = *(const bf16x8*)(c.proj + (size_t)(rowbase + qabs) * INC + CC_Q + h * 64 + d0 * 16 + c.hi * 8);
    asm volatile("" : "+v"(qf[0]), "+v"(qf[1]), "+v"(qf[2]), "+v"(qf[3]));
    float C = 0.f; f32x16 o[2]; o[0] = (f32x16){}; o[1] = (f32x16){};
    bool wdone = false;
    const int T0 = 4 * qb + 3;
    VM_WAIT();
    const KVB kvb = kv_base<false>(c, rowbase, CC_K + h * 64, 0, CC_V + h * 64);
    stage_kvb(c, 0, kvb, 64 * T0);
    stage_kvb(c, 1, kvb, 64 * (T0 - 1));
    WAIT_BAR(2);
    int sl = 0;
    for (int i = 0, t = T0; t >= 0; --t, ++i) {
        ldsp cur = c.lds + A_KV + sl * 16384;
        if (t > 1) stage_kvb(c, sl >= 1 ? sl - 1 : 2, kvb, 64 * (t - 2));
        if (c.tid == 0) misc[16 + ((i + 2) & 3)] = 0u;
        const int k0 = 64 * t;
        if (!wdone && k0 <= qmin + 31) {
            f32x16 y0, y1;
            qk_tile<4, false>(y0, y1, cur, qf, c.r32, c.hi);
            const int dbase = qabs - k0;
            f32x16 L0, L1;
#pragma unroll
            for (int r = 0; r < 16; ++r) {
                const int d0 = dbase - crow(r, c.hi), d1 = d0 - 32;
                { const float y = y0[r], a = __builtin_amdgcn_logf(1.0f + __builtin_amdgcn_exp2f(-fabsf(y))); L0[r] = d0 > 0 ? -(fmaxf(y, 0.f) + a) : 0.f; y0[r] = fminf(y, 0.f) - a; }
                { const float y = y1[r], a = __builtin_amdgcn_logf(1.0f + __builtin_amdgcn_exp2f(-fabsf(y))); L1[r] = d1 > 0 ? -(fmaxf(y, 0.f) + a) : 0.f; y1[r] = fminf(y, 0.f) - a; }
            }
            float Te[2][4], To[2][4];
#pragma unroll
            for (int k = 0; k < 4; ++k) {
                { const float a0 = L0[4 * k], a1 = L0[4 * k + 1], a2 = L0[4 * k + 2], a3 = L0[4 * k + 3]; const float s2 = a3, s1 = a3 + a2, s0 = s1 + a1, T = s0 + a0;
                  L0[4 * k] = s0; L0[4 * k + 1] = s1; L0[4 * k + 2] = s2; L0[4 * k + 3] = 0.f;
                  auto rr = __builtin_amdgcn_permlane32_swap(__float_as_uint(T), __float_as_uint(T), false, false); Te[0][k] = __uint_as_float(rr[0]); To[0][k] = __uint_as_float(rr[1]); }
                { const float a0 = L1[4 * k], a1 = L1[4 * k + 1], a2 = L1[4 * k + 2], a3 = L1[4 * k + 3]; const float s2 = a3, s1 = a3 + a2, s0 = s1 + a1, T = s0 + a0;
                  L1[4 * k] = s0; L1[4 * k + 1] = s1; L1[4 * k + 2] = s2; L1[4 * k + 3] = 0.f;
                  auto rr = __builtin_amdgcn_permlane32_swap(__float_as_uint(T), __float_as_uint(T), false, false); Te[1][k] = __uint_as_float(rr[0]); To[1][k] = __uint_as_float(rr[1]); }
            }
            float run = 0.f, Bown[2][4];
#pragma unroll
            for (int ph = 1; ph >= 0; --ph)
#pragma unroll
                for (int k = 3; k >= 0; --k) { const float Bo = run; run += To[ph][k]; const float Be = run; run += Te[ph][k]; Bown[ph][k] = c.hi ? Bo : Be; }
#pragma unroll
            for (int r = 0; r < 16; ++r) {
                const int d0 = dbase - crow(r, c.hi), d1 = d0 - 32;
                y0[r] = d0 > 0 ? __builtin_amdgcn_exp2f(y0[r] + (C + Bown[0][r >> 2] + L0[r])) : 0.f;
                y1[r] = d1 > 0 ? __builtin_amdgcn_exp2f(y1[r] + (C + Bown[1][r >> 2] + L1[r])) : 0.f;
            }
            C += run;
            bf16x8 pa[4];
            pack_p(y0, y1, pa);
            pv_tile<1>(o, o, cur + 8192, pa, pa, c.lane, c.hi);
            if (__all(C < -150.0f)) wdone = true;
        }
        if ((wdone || t == 0) && c.lane == 0) __hip_atomic_fetch_add(misc + 16 + (i & 3), 1u, __ATOMIC_RELAXED, __HIP_MEMORY_SCOPE_WORKGROUP);
        if (t > 1) WAIT_BAR(2); else WAIT_BAR(0);
        sl = sl == 2 ? 0 : sl + 1;
        if (misc[16 + (i & 3)] == 8u) break;
    }
    float one[16];
#pragma unroll
    for (int r = 0; r < 16; ++r) one[r] = 1.0f;
    LAS float* stg = (LAS float*)(c.lds + A_OST + c.wid * 8192);
    stage_o(stg, o, one, c.r32, c.hi);
    store_o<false>(stg, c.o + (size_t)(rowbase + qmin) * DM + 512 + h * 64, c.lane, nullptr, 1.0f);
}

__device__ __forceinline__ Ctx make_ctx(const Frame& F) {
    Ctx c; c.lds = F.lds; c.proj = (const bf16_t*)(F.ws + WS_PROJ); c.o = (bf16_t*)(F.ws + WS_O); c.tid = F.tid; c.lane = F.lane; c.wid = F.wave; c.r32 = F.lane & 31; c.hi = F.lane >> 5; c.shadow = 0; return c;
}
#define ATT_FRESH() { int ln_ = F.lane; asm volatile("" : "+v"(ln_)); c.lane = ln_; c.tid = F.wave * 64 + ln_; c.r32 = ln_ & 31; c.hi = ln_ >> 5; }
#define ATT_QUEUE(k, NITEMS, ...) for (;;) { __syncthreads(); if (F.tid == 0) misc[0] = __hip_atomic_fetch_add(qh + (k) * 64, 1u, __ATOMIC_RELAXED, __HIP_MEMORY_SCOPE_AGENT); __syncthreads(); \
        const int item = (int)misc[0]; if (item >= (NITEMS)) break; ATT_FRESH(); __VA_ARGS__; }
#define ATT_STATIC(NITEMS, ...) for (int item = F.bid; item < (NITEMS); item += F.G) { __syncthreads(); ATT_FRESH(); __VA_ARGS__; }
__device__ __forceinline__ void ph_attn_select(const Frame& F, int l) {
    const int nl = F.G, me = F.bid;
    Ctx c = make_ctx(F);
    LAS unsigned* misc = (LAS unsigned*)(F.lds + A_MISC);
    const float* kmsum = (const float*)((const unsigned char*)F.ctl + CTL_KMEAN) + (size_t)l * 128 * 256;
    unsigned* mcnt = (unsigned*)((unsigned char*)F.ctl + CTL_MCNT) + (size_t)l * 512 * 64; unsigned* mlist = (unsigned*)(F.ws + WS_MLIST);
    __syncthreads();
    if (F.tid == 0) { unsigned sp = 0u; while (__hip_atomic_load(F.ctl + CW_KDONE + l * 64, __ATOMIC_RELAXED, __HIP_MEMORY_SCOPE_AGENT) < (unsigned)((NTOK / 256) * 8)) { __builtin_amdgcn_s_sleep(2); if (++sp > (1u << 26)) break; } }
    __syncthreads();
    __builtin_amdgcn_fence(__ATOMIC_ACQUIRE, "agent");
    for (int item = me; item < 496; item += nl) { __syncthreads(); ATT_FRESH(); const int qb = 31 - (item >> 4), b = (item >> 2) & 3, h = item & 3; moba_select_unit(c, b, h, qb, kmsum, mcnt, mlist); }
}
__device__ __forceinline__ void ph_attn(const Frame& F, int l, int rep = 0, int amask = 15) {
    Ctx c = make_ctx(F); c.shadow = rep;
    LAS unsigned* misc = (LAS unsigned*)(F.lds + A_MISC);
    build_tables(c, F.in[1]);
    const float lam = __uint_as_float(__hip_atomic_load(F.ctl + CW_LAM + l, __ATOMIC_RELAXED, __HIP_MEMORY_SCOPE_AGENT));
    unsigned* mcnt = (unsigned*)((unsigned char*)F.ctl + CTL_MCNT) + (size_t)l * 512 * 64; const unsigned* mlist = (const unsigned*)(F.ws + WS_MLIST);
    bf16_t* po = (bf16_t*)(F.ws + WS_MPO); float* pml = (float*)(F.ws + WS_MML);
    unsigned* qh = F.ctl + CW_Q + l * 8 * 64 + rep * 2048;
    LAS int* pre = (LAS int*)(F.lds + A_MISC) + 320;
    LAS int* lcnt = (LAS int*)(F.lds + A_MISC) + 832;
    { const int cn = (int)__hip_atomic_load(mcnt + (size_t)F.tid * 64, __ATOMIC_RELAXED, __HIP_MEMORY_SCOPE_AGENT); pre[F.tid] = (cn + 255) >> 8; lcnt[F.tid] = cn; }
    __syncthreads();
    for (int d = 1; d < 512; d <<= 1) { const int v = (F.tid >= d) ? pre[F.tid - d] : 0; __syncthreads(); pre[F.tid] += v; __syncthreads(); }
    const int NSP = pre[511];
#ifndef AMASK
#define AMASK 15
#endif
    if (amask & AMASK & 1) ATT_QUEUE(0, 512, { const int qb = 31 - (item >> 4), b = (item >> 2) & 3, h = item & 3; diff_unit(c, b, h, qb, lam, F.in[8] + l * 64, 1.0f - lam_init_of(l)); })
    if (amask & AMASK & 2) {
        { ATT_FRESH(); moba_units(c, F.bid, F.G, NSP, pre, lcnt, mlist, po, pml); }
    }
    if (amask & AMASK & 4) ATT_STATIC(512, { const int qb = 31 - (item >> 4), b = (item >> 2) & 3, h = item & 3; swa_unit(c, b, h, qb, F.in[9][l * 4 + h]); })
    if (amask & AMASK & 8) ATT_STATIC(512, { const int qb = 31 - (item >> 4), b = (item >> 2) & 3, h = item & 3; sb_unit(c, b, h, qb); })
}
#undef ATT_QUEUE
#undef ATT_STATIC
#undef ATT_FRESH
}

constexpr int NPL = 9, NPH = 1 + NPL * DEPTH;
struct Persist { int wave0, lo, hi; };
__device__ __forceinline__ void refresh(Frame& F, const Persist& P) {
    const unsigned char __attribute__((address_space(4)))* kp = (const unsigned char __attribute__((address_space(4)))*)__builtin_amdgcn_kernarg_segment_ptr();
    asm volatile("" : "+s"(kp));
    F.in = (karg_in_t)kp;
    F.out = *(float* __attribute__((address_space(4)))*)(kp + 176);
    F.ws = *(unsigned char* __attribute__((address_space(4)))*)(kp + 184);
    F.ctl = (unsigned*)(F.ws + WS_CTL);
    int w = P.wave0; asm volatile("" : "+s"(w));
    unsigned ones = ~0u; asm volatile("" : "+s"(ones));
    int ln = (int)__builtin_amdgcn_mbcnt_hi(ones, __builtin_amdgcn_mbcnt_lo(ones, 0u)); asm volatile("" : "+v"(ln));
    F.wave = w; F.lane = ln; F.tid = w * 64 + ln;
    int g = (int)gridDim.x, b = (int)blockIdx.x; asm volatile("" : "+s"(g), "+s"(b));
    F.G = g; F.bid = b;
    unsigned l0 = 0; asm volatile("" : "+s"(l0));
    F.lds = (ldsp)(uintptr_t)l0;
}
#ifndef KMASK
#define KMASK 0xffff
#endif
#define KON(j) ((KMASK >> (j)) & 1)
#define FULLBAR() do { refresh(F, P); XcdBarrier b_; b_.bar = F.ctl + CW_BAR; b_.x = barx; b_.st = (volatile LAS unsigned*)(F.lds + LDS_XB); xcd_barrier(b_, F.tid == 0); } while (0)
#define IN(k) (lo <= (k) && (k) < hi)
#define SEAM(k) do { if (IN(k) && IN((k) + 1)) { refresh(F, P); XcdBarrier b_; b_.bar = F.ctl + CW_BAR; b_.x = barx; b_.st = (volatile LAS unsigned*)(F.lds + LDS_XB); xcd_barrier(b_, F.tid == 0); } } while (0)

template <int l>
__device__ __forceinline__ void run_layer(Frame& F, const Persist& P, const int lo, const int hi, const unsigned barx) {
        const int pb = 1 + NPL * l;
        if (KON(0) && IN(pb + 0)) {
            refresh(F, P);
            SchedProj S{(const char*)(F.ws + WS_H), (const char*)(F.ws + WS_WIN), F.G, F.bid};
            EpiBf16 E{(bf16_t*)(F.ws + WS_PROJ), INC, (float*)((unsigned char*)F.ctl + CTL_KMEAN) + (size_t)l * 128 * 256, F.ctl + CW_KDONE + l * 64};
            pg8::gemm_stream(F.lds, F.tid, S, E);
            refresh(F, P); att::ph_attn_select(F, l);
        }
        SEAM(pb + 0);
        if (KON(2) && IN(pb + 1)) { refresh(F, P); att::ph_attn(F, l); }
#ifdef PROBE_REP_ATT
        if (IN(pb + 1)) { refresh(F, P); XcdBarrier b_; b_.bar = F.ctl + CW_BAR; b_.x = barx; b_.st = (volatile LAS unsigned*)(F.lds + LDS_XB); xcd_barrier(b_, F.tid == 0); refresh(F, P); att::ph_attn(F, l, 1, PROBE_REP_ATT); }
#endif
        SEAM(pb + 1);
        if (KON(3) && IN(pb + 2)) { refresh(F, P); att::moba_combine(F, (const bf16_t*)(F.ws + WS_MPO), (const float*)(F.ws + WS_MML), (bf16_t*)(F.ws + WS_O)); }
        SEAM(pb + 2);
        if (KON(4) && IN(pb + 3)) {
            refresh(F, P);
            SchedGate S{(const char*)(F.ws + WS_H8), (const char*)(F.ws + WS_O), (const char*)(F.ws + WS_WG), (const char*)(F.ws + WS_WBR), F.G, F.bid};
            EpiGate E{(bf16_t*)(F.ws + WS_MERGED), F.ws + WS_S + (size_t)F.bid * 131072};
            pg8::gemm_stream<EpiGate, SchedGate, 2>(F.lds, F.tid, S, E);
        }
        SEAM(pb + 3);
        if (KON(5) && IN(pb + 4)) {
            refresh(F, P);
            SchedWo S{(const char*)(F.ws + WS_MERGED), (const char*)(F.ws + WS_WO), F.G, F.bid};
            EpiResid<l == 0> E{F.in[0], (const bf16_t*)(F.ws + WS_R), (bf16_t*)(F.ws + WS_R)};
            pg8::gemm_stream(F.lds, F.tid, S, E);
        }
        SEAM(pb + 4);
        if (KON(6) && IN(pb + 5)) { refresh(F, P); ph_route(F, l, (const bf16_t*)(F.ws + WS_R), F.ws + WS_H2, (unsigned*)(F.ws + WS_TOK), (unsigned*)(F.ws + WS_ELIST)); }
        SEAM(pb + 5);
        if (KON(8) && IN(pb + 6)) {
            refresh(F, P); moe_tables(F, l);
            SchedMoe<1024u, 1024u, 8, true> S{F.lds, (const char*)(F.ws + WS_H2), (const char*)(F.ws + WS_W13), F.G, F.bid, (const unsigned*)(F.ws + WS_ELIST)};
            EpiSilu E{F.ws + WS_HID, 1.0f / 32.0f};
            pg8::gemm_stream<EpiSilu, SchedMoe<1024u, 1024u, 8, true>, 1>(F.lds, F.tid, S, E);
        }
        SEAM(pb + 6);
        if (KON(9) && IN(pb + 7)) {
            refresh(F, P); moe_tables(F, l);
            SchedMoe<512u, 512u, 4, false> S{F.lds, (const char*)(F.ws + WS_HID), (const char*)(F.ws + WS_W2), F.G, F.bid, nullptr};
            EpiFp8 E{F.ws + WS_Y8, DM, 8.0f / 16.0f};
            pg8::gemm_stream<EpiFp8, SchedMoe<512u, 512u, 4, false>, 1>(F.lds, F.tid, S, E);
        }
        SEAM(pb + 7);
        if (KON(10) && IN(pb + 8)) {
            refresh(F, P);
            if (l + 1 < DEPTH) { ph_convert(F, l + 1); ph_combine(F, l, (const bf16_t*)(F.ws + WS_R), F.ws + WS_Y8, (const unsigned*)(F.ws + WS_TOK), F.in[2] + (size_t)(l + 1) * DM, F.out, (bf16_t*)(F.ws + WS_R), (bf16_t*)(F.ws + WS_H), F.ws + WS_H8, false); }
            else ph_combine(F, l, (const bf16_t*)(F.ws + WS_R), F.ws + WS_Y8, (const unsigned*)(F.ws + WS_TOK), F.in[21], F.out, (bf16_t*)(F.ws + WS_R), (bf16_t*)(F.ws + WS_H), F.ws + WS_H8, true);
        }
        SEAM(pb + 8);
    }
__global__ void __launch_bounds__(512, 2) mk_fwd(Args args_unused) {
    extern __shared__ __attribute__((aligned(16))) unsigned char lds_raw[];
    Frame F; Persist P;
    P.wave0 = __builtin_amdgcn_readfirstlane((int)threadIdx.x >> 6);
    { const unsigned char __attribute__((address_space(4)))* kp = (const unsigned char __attribute__((address_space(4)))*)__builtin_amdgcn_kernarg_segment_ptr();
      P.lo = *(const int __attribute__((address_space(4)))*)(kp + 192); P.hi = *(const int __attribute__((address_space(4)))*)(kp + 196); }
    const int lo = P.lo, hi = P.hi;
    const bool fused = (hi - lo) > 1;
    refresh(F, P);
    if ((ldsp)lds_raw != F.lds) __builtin_trap();
    if (F.tid < 4) ((LAS unsigned*)(F.lds + LDS_XB))[F.tid] = 0u;
    __syncthreads();
    XcdBarrier bar; bar.bar = F.ctl + CW_BAR; bar.x = 0; bar.st = (volatile LAS unsigned*)(F.lds + LDS_XB);
    if (fused) bar = xcd_barrier_post(F.ctl + CW_BAR, (volatile LAS unsigned*)(F.lds + LDS_XB), F.tid == 0);
    const unsigned barx = bar.x;
    if (KON(15) && IN(0)) { refresh(F, P); ph_convert(F, 0); ph_norm(F, F.in[0], F.in[2], (bf16_t*)(F.ws + WS_H), F.ws + WS_H8); ph_lam(F); }
    SEAM(0);
    run_layer<0>(F, P, lo, hi, barx);
    run_layer<1>(F, P, lo, hi, barx);
#undef IN
#undef SEAM
}

extern "C" void kernel_launch(void* const* d_in, const int* in_sizes, int n_in, void* d_out, int out_size, void* d_ws, size_t ws_size, hipStream_t stream) {
    static int grid = 0;
    if (grid == 0) {
        if (n_in != 22 || in_sizes[0] != NTOK * DM || out_size != NTOK * DM || ws_size < WS_END) { fprintf(stderr, "kernel_launch: unexpected shapes (n_in %d, in0 %d, out %d, ws %zu < %zu)\n", n_in, n_in > 0 ? in_sizes[0] : -1, out_size, ws_size, (size_t)WS_END); grid = -1; return; }
        int dev = 0, cus = 0, per_cu = 0;
        if (hipGetDevice(&dev) != hipSuccess || hipDeviceGetAttribute(&cus, hipDeviceAttributeMultiprocessorCount, dev) != hipSuccess) { grid = -1; return; }
        if (hipFuncSetAttribute((const void*)mk_fwd, hipFuncAttributeMaxDynamicSharedMemorySize, LDS_BYTES) != hipSuccess) { fprintf(stderr, "kernel_launch: hipFuncSetAttribute failed\n"); grid = -1; return; }
        if (hipOccupancyMaxActiveBlocksPerMultiprocessor(&per_cu, (const void*)mk_fwd, 512, LDS_BYTES) != hipSuccess || per_cu < 1) fprintf(stderr, "kernel_launch: occupancy query reports %d\n", per_cu);
        (void)hipGetLastError();
        grid = cus;
    }
    if (grid < 0) return;
    if (hipMemsetAsync((char*)d_ws + WS_CTL, 0, CTL_ZERO_BYTES, stream) != hipSuccess) return;
    Args a{};
    for (int i = 0; i < 22; ++i) a.in[i] = (const float*)d_in[i];
    a.out = (float*)d_out; a.ws = (unsigned char*)d_ws;
#if MK_N_LAUNCHES == 1
    a.ph_lo = 0; a.ph_hi = NPH;
    hipLaunchKernelGGL(mk_fwd, dim3(grid), dim3(512), LDS_BYTES, stream, a);
#else
    for (int p = 0; p < NPH; ++p) { a.ph_lo = p; a.ph_hi = p + 1; hipLaunchKernelGGL(mk_fwd, dim3(grid), dim3(512), LDS_BYTES, stream, a); }
#endif
    const hipError_t le = hipPeekAtLastError();
    if (le != hipSuccess) fprintf(stderr, "kernel_launch: launch failed: %s\n", hipGetErrorName(le));
}
```

```cpp
#include <hip/hip_runtime.h>
#include <cstdio>
#include <cstdint>

#ifndef MK_N_LAUNCHES
#define MK_N_LAUNCHES 1
#endif

#define GAS __attribute__((address_space(1)))
#define LAS __attribute__((address_space(3)))
typedef unsigned short bf16_t;
typedef short bf16x8 __attribute__((ext_vector_type(8)));
typedef short s16x4 __attribute__((ext_vector_type(4)));
typedef float f32x4 __attribute__((ext_vector_type(4)));
typedef float f32x16 __attribute__((ext_vector_type(16)));
typedef unsigned u32x4 __attribute__((ext_vector_type(4)));
typedef unsigned u32x2 __attribute__((ext_vector_type(2)));
typedef float f32x2_t __attribute__((ext_vector_type(2)));
typedef __bf16 bf16x2_t __attribute__((ext_vector_type(2)));
typedef LAS unsigned char* ldsp;

constexpr int DM = 1024, NB = 4, SEQ = 8192, NTOK = NB * SEQ, DEPTH = 2;
constexpr int INC = 2816;
constexpr int NEXP = 32, DEXP = 512;
constexpr int MOE_ROWS = 2 * NTOK + NEXP * 256;
constexpr float NORM_EPS = 1e-6f;
constexpr float LOG2E = 1.4426950408889634f;
constexpr int CA_Q = 0, CA_K = 256, CA_V = 512;
constexpr int CB_Q1 = 768, CB_Q2 = 896, CB_K1 = 1024, CB_K2 = 1152, CB_V = 1280;
constexpr int CC_Q = 1536, CC_K = 1792, CC_V = 2048;
constexpr int CD_Q = 2304, CD_K = 2560, CD_V = 2688;

constexpr size_t MiB = 1u << 20;
constexpr size_t WS_CTL = 0, CTL_ZERO_BYTES = 1024 * 1024;
constexpr size_t WS_WIN = 1 * MiB, WS_WG = 7 * MiB, WS_WBR = 15 * MiB, WS_WO = 17 * MiB, WS_W13 = 19 * MiB, WS_W2 = 83 * MiB;
constexpr size_t WS_R = 115 * MiB;
constexpr size_t WS_H = 355 * MiB;
constexpr size_t WS_PROJ = 179 * MiB;
constexpr size_t WS_O = 355 * MiB;
constexpr size_t WS_MERGED = 419 * MiB;
constexpr size_t WS_H2 = 387 * MiB;
constexpr size_t WS_ELIST = 487 * MiB;
constexpr size_t WS_Y8 = 251 * MiB;
constexpr size_t WS_HID = 323 * MiB;
constexpr size_t WS_S = 483 * MiB;
constexpr size_t WS_TOK = 515 * MiB;
constexpr size_t WS_H8 = 516 * MiB;
constexpr size_t WS_END = 548 * MiB;
static_assert(WS_Y8 + (size_t)MOE_ROWS * 1024 <= WS_HID && WS_HID + (size_t)MOE_ROWS * 512 <= WS_H2 && WS_H2 + (size_t)NTOK * 1024 <= WS_MERGED, "moe overlay");
constexpr int CW_BAR = 4096;
constexpr int CW_Q = 8192;
constexpr int CW_CNT = 12288;
constexpr int CW_LAM = 20480;
constexpr int CW_HDONE = 32768;
constexpr int CW_KDONE = 20480 + 64;
constexpr size_t CTL_KMEAN = 256 * 1024;
constexpr size_t CTL_MCNT = 512 * 1024;
constexpr size_t WS_MPO = 419 * MiB;
constexpr size_t WS_MML = 483 * MiB;
constexpr size_t WS_MLIST = 487 * MiB;

constexpr int LDS_BYTES = 160 * 1024;
constexpr int LDS_XB = LDS_BYTES - 16;

#define LDS_WAIT() asm volatile("s_waitcnt lgkmcnt(0)" ::: "memory")
#define VM_WAIT() asm volatile("s_waitcnt vmcnt(0)" ::: "memory")
__device__ __forceinline__ unsigned cvtpk(float lo, float hi) { f32x2_t v = {lo, hi}; bf16x2_t b = __builtin_convertvector(v, bf16x2_t); return __builtin_bit_cast(unsigned, b); }
__device__ __forceinline__ unsigned pk_fp8x4(float a, float b, float c, float d) { int w = 0; w = __builtin_amdgcn_cvt_pk_fp8_f32(a, b, w, false); w = __builtin_amdgcn_cvt_pk_fp8_f32(c, d, w, true); return (unsigned)w; }
__device__ __forceinline__ float bf_lo(unsigned w) { return __uint_as_float(w << 16); }
__device__ __forceinline__ float bf_hi(unsigned w) { return __uint_as_float(w & 0xffff0000u); }
__device__ __forceinline__ float shflx(float v, int mask, int lane) { return __int_as_float(__builtin_amdgcn_ds_bpermute((lane ^ mask) << 2, __float_as_int(v))); }
__device__ __forceinline__ int shflxi(int v, int mask, int lane) { return __builtin_amdgcn_ds_bpermute((lane ^ mask) << 2, v); }
template <int CTRL> __device__ __forceinline__ float dpp_mov(float v) { return __int_as_float(__builtin_amdgcn_update_dpp(0, __float_as_int(v), CTRL, 0xf, 0xf, true)); }
__device__ __forceinline__ float wave_sum(float v, int lane) {
    (void)lane;
    v += dpp_mov<0xB1>(v); v += dpp_mov<0x4E>(v); v += dpp_mov<0x141>(v); v += dpp_mov<0x140>(v);
    { auto rr = __builtin_amdgcn_permlane16_swap(__float_as_uint(v), __float_as_uint(v), false, false); v = __uint_as_float(rr[0]) + __uint_as_float(rr[1]); }
    { auto rr = __builtin_amdgcn_permlane32_swap(__float_as_uint(v), __float_as_uint(v), false, false); v = __uint_as_float(rr[0]) + __uint_as_float(rr[1]); }
    return v;
}

#define XB_TMO      128
#define XB_XCNT(j)  (256  + 64 * (j))
#define XB_XSUB(j)  (1280 + 64 * (j))
#define XB_XGEN(j)  (2304 + 64 * (j))
#define XB_TOP      3328
#define XB_TOPGEN   3392
#define XCD_BAR_WORDS 3456
#define XB_SPIN_CAP (1u << 18)
__device__ __forceinline__ unsigned xb_ld(unsigned* p)              { return __hip_atomic_load(p, __ATOMIC_RELAXED, __HIP_MEMORY_SCOPE_AGENT); }
__device__ __forceinline__ unsigned xb_add(unsigned* p, unsigned v) { return __hip_atomic_fetch_add(p, v, __ATOMIC_RELAXED, __HIP_MEMORY_SCOPE_AGENT); }
__device__ __forceinline__ unsigned xb_xcc_id() { return (unsigned)__builtin_amdgcn_s_getreg((3 << 11) | 20) & 0xFu; }
#define XB_SPIN(cond, bar) do { unsigned _sp = 0; while (cond) { __builtin_amdgcn_s_sleep(1); \
    if ((++_sp & 255u) == 0u) { if (xb_ld(&(bar)[XB_TMO])) break; if (_sp > XB_SPIN_CAP) { atomicAdd(&(bar)[XB_TMO], 1u); break; } } } } while (0)
struct XcdBarrier { unsigned* bar; unsigned x; volatile LAS unsigned* st; };
__device__ __forceinline__ XcdBarrier xcd_barrier_post(unsigned* bar, volatile LAS unsigned* st, const bool leader) {
    XcdBarrier b; b.bar = bar; b.x = xb_xcc_id(); b.st = st;
    if (leader) (void)xb_add(&bar[XB_XCNT(b.x)], 1u);
    return b;
}
__device__ __forceinline__ void xcd_barrier_complete(unsigned* bar, unsigned x, unsigned& nloc, unsigned& nx) {
    const unsigned G = gridDim.x * gridDim.y * gridDim.z;
    unsigned sum, cnt, mine, sp = 0u;
    for (;;) {
        sum = 0u; cnt = 0u; mine = 0u;
#pragma unroll 1
        for (unsigned j = 0; j < 16; ++j) { const unsigned c = xb_ld(&bar[XB_XCNT(j)]); sum += c; cnt += (c > 0u) ? 1u : 0u; mine = (j == x) ? c : mine; }
        if (sum == G) break;
        __builtin_amdgcn_s_sleep(1);
        if ((++sp & 255u) == 0u) { if (xb_ld(&bar[XB_TMO])) break; if (sp > XB_SPIN_CAP) { atomicAdd(&bar[XB_TMO], 1u); break; } }
    }
    nloc = mine > 0u ? mine : 1u; nx = cnt > 0u ? cnt : 1u;
}
__device__ __forceinline__ void xcd_barrier(const XcdBarrier& b, const bool leader  ) {
    asm volatile("s_waitcnt vmcnt(0)" ::: "memory");
    __syncthreads();
    if (leader) {
        unsigned* bar = b.bar;
        __builtin_amdgcn_s_waitcnt(0);
        unsigned nloc = b.st[0], nx = b.st[1];
        if (nloc == 0u) { xcd_barrier_complete(bar, b.x, nloc, nx); b.st[0] = nloc; b.st[1] = nx; }
        const unsigned old = xb_add(&bar[XB_XSUB(b.x)], 1u);
        const unsigned gen = old / nloc;
        if (old + 1u == (gen + 1u) * nloc) {
            __builtin_amdgcn_fence(__ATOMIC_RELEASE, "agent");
            asm volatile("s_waitcnt vmcnt(0)" ::: "memory");
            const unsigned og = xb_add(&bar[XB_TOP], 1u);
            const unsigned tg = og / nx;
            if (og + 1u == (tg + 1u) * nx) xb_add(&bar[XB_TOPGEN], 1u);
            else XB_SPIN(xb_ld(&bar[XB_TOPGEN]) == tg, bar);
            __builtin_amdgcn_fence(__ATOMIC_ACQUIRE, "agent");
            xb_add(&bar[XB_XGEN(b.x)], 1u);
            asm volatile("s_waitcnt vmcnt(0)" ::: "memory");
        } else {
            XB_SPIN(xb_ld(&bar[XB_XGEN(b.x)]) == gen, bar);
            __builtin_amdgcn_fence(__ATOMIC_ACQUIRE, "agent");
            asm volatile("s_waitcnt vmcnt(0)" ::: "memory");
        }
    }
    __syncthreads();
}

struct Args { const float* in[22]; float* out; unsigned char* ws; int ph_lo, ph_hi; };
typedef const float* __attribute__((address_space(4))) const* karg_in_t;
struct Frame {
    ldsp lds; unsigned* ctl; unsigned char* ws; karg_in_t in; float* out;
    int tid, lane, wave, G, bid;
};

namespace pg8 {
constexpr int BM = 256, BK = 64, HALF = 128, HTB = HALF * BK * 2, STAGE_BYTES = 8 * HTB, NXCD = 8, WGM = 8;
__device__ __forceinline__ int lds_byte(int r, int c) { const int st = (r >> 4) * 2 + (c >> 5), rr = r & 15, cc = c & 31, ob = rr * 64 + cc * 2; return st * 1024 + (ob ^ (((ob >> 9) & 1) << 5)); }
__device__ __forceinline__ void stage_rc(int b, int& R, int& C) { const int st = b / 1024, sb = b % 1024, swz = sb ^ (((sb >> 9) & 1) << 5); R = (st >> 1) * 16 + swz / 64; C = (st & 1) * 32 + (swz % 64) / 2; }
__device__ __forceinline__ int perm32(int rho) { const int n = rho >> 4, i = rho & 15; return 8 * (i >> 2) + 4 * n + (i & 3); }

struct GU { const char* A; const char* B; unsigned pa, pb; int nt; int pm, pn, aux; int f8; const unsigned* rows; int nrows; };

__device__ __forceinline__ bool linear_tile(int nM, int nN, long L, int& pm, int& pn) {
    const int nwg = nM * nN; if (L >= nwg) return false;
    int wgid = (int)L; { const int q = nwg / NXCD, r = nwg % NXCD, xcd = wgid % NXCD, off = wgid / NXCD; wgid = (xcd < r ? xcd * (q + 1) : r * (q + 1) + (xcd - r) * q) + off; }
    const int nig = WGM * nN, gid = wgid / nig, fm = gid * WGM, gsz = (nM - fm) < WGM ? (nM - fm) : WGM;
    pm = fm + ((wgid % nig) % gsz); pn = (wgid % nig) / gsz; return true;
}
__device__ __forceinline__ bool static_tile(int nM, int nN, int G, int c, int i, int& pm, int& pn) { return linear_tile(nM, nN, (long)i * G + c, pm, pn); }

typedef int v8i_t __attribute__((ext_vector_type(8)));
typedef int v4i_t __attribute__((ext_vector_type(4)));
template <class Epi, class Sched, int MODE = 0>
__device__ __forceinline__ void gemm_stream(ldsp lds, const int tid, const Sched& S, const Epi& E) {
    const int wid = __builtin_amdgcn_readfirstlane(tid >> 6), lane = tid & 63, wr = wid >> 2, wc = wid & 3, fr = lane & 15, fq = lane >> 4;
    GU cur, nxt; int ui = 0;
    if (!S.next(0, cur)) return;
    unsigned voffA[2], voffA2[2], voffB[2]; size_t hA, hB;
#define PG8_SETOFF(u) do { int _t = tid; asm volatile("" : "+v"(_t)); _Pragma("unroll") for (int _i = 0; _i < 2; ++_i) { int _R, _C; stage_rc(_t * 16 + _i * 8192, _R, _C); \
        const int _Rb = Epi::PERM ? ((_R & ~31) + perm32(_R & 31)) : _R; voffB[_i] = (unsigned)_Rb * (u).pb + (unsigned)(_C * 2); \
        if (Sched::GATHER) { const unsigned _r0 = (_R < (u).nrows) ? (u).rows[_R] : 0u, _r1 = (_R + HALF < (u).nrows) ? (u).rows[_R + HALF] : 0u; voffA[_i] = _r0 * (u).pa + (unsigned)(_C * 2); voffA2[_i] = _r1 * (u).pa + (unsigned)(_C * 2); } \
        else { voffA[_i] = (unsigned)_R * (u).pa + (unsigned)(_C * 2); } } \
        hA = (size_t)HALF * (u).pa; hB = (size_t)HALF * (u).pb; } while (0)
    PG8_SETOFF(cur);
    const size_t kstep = (size_t)(BK * 2);
    const unsigned ldsw = (unsigned)wid * 1024u;
    bool f8 = (MODE == 1) || (MODE == 2 && cur.f8 != 0);
    int aoff, boff;
#define PG8_SETFRAG() do { int _t = tid; asm volatile("" : "+v"(_t)); const int _fr = _t & 15, _fq = (_t >> 4) & 3; \
        aoff = lds_byte(wr * 64 + _fr, _fq * (f8 ? 16 : 8)); boff = lds_byte(wc * 32 + _fr, _fq * (f8 ? 16 : 8)); } while (0)
    PG8_SETFRAG();
#define PG8_SA(b, h) (((b) * 2 + (h)) * HTB)
#define PG8_SB(b, h) ((4 + (b) * 2 + (h)) * HTB)
#define PG8_STAGE(bufoff, gbase, voff) do { _Pragma("unroll") for (int _i = 0; _i < 2; ++_i) \
        __builtin_amdgcn_global_load_lds((const unsigned*)((const char*)(gbase) + (voff)[_i]), (LAS unsigned*)(lds + (bufoff) + ldsw + _i * 8192), 16, 0, ((bufoff) < 4 * HTB) ? Sched::AUXA : 0); } while (0)
#define PG8_STAGE_A2(bufoff, gbase) do { if (Sched::GATHER) PG8_STAGE(bufoff, gbase, voffA2); else PG8_STAGE(bufoff, (gbase) + hA, voffA); } while (0)
#define PG8_LDA(dst, b, h) do { _Pragma("unroll") for (int m = 0; m < 4; ++m) _Pragma("unroll") for (int k = 0; k < 2; ++k) dst[m][k] = *(const LAS bf16x8*)(lds + PG8_SA(b, h) + aoff + m * 2048 + k * KOFF_); } while (0)
#define PG8_LDB(dst, b, h) do { _Pragma("unroll") for (int n = 0; n < 2; ++n) _Pragma("unroll") for (int k = 0; k < 2; ++k) dst[n][k] = *(const LAS bf16x8*)(lds + PG8_SB(b, h) + boff + n * 2048 + k * KOFF_); } while (0)
#define PG8_PAIR(x) __builtin_shufflevector(__builtin_bit_cast(v4i_t, x[0]), __builtin_bit_cast(v4i_t, x[1]), 0, 1, 2, 3, 4, 5, 6, 7)
#define PG8_MMA_F8(ai, bj, At, Bt) do { __builtin_amdgcn_s_setprio(1); _Pragma("unroll") for (int m = 0; m < 4; ++m) _Pragma("unroll") for (int n = 0; n < 2; ++n) \
            acc[ai][bj][m][n] = __builtin_amdgcn_mfma_scale_f32_16x16x128_f8f6f4(PG8_PAIR(Bt[n]), PG8_PAIR(At[m]), acc[ai][bj][m][n], 0, 0, 0, 0x7f7f7f7f, 0, 0x7f7f7f7f); \
        __builtin_amdgcn_s_setprio(0); } while (0)
#define PG8_MMA_BF(ai, bj, At, Bt) do { __builtin_amdgcn_s_setprio(1); _Pragma("unroll") for (int m = 0; m < 4; ++m) _Pragma("unroll") for (int n = 0; n < 2; ++n) _Pragma("unroll") for (int k = 0; k < 2; ++k) \
            acc[ai][bj][m][n] = __builtin_amdgcn_mfma_f32_16x16x32_bf16(Bt[n][k], At[m][k], acc[ai][bj][m][n], 0, 0, 0); \
        __builtin_amdgcn_s_setprio(0); } while (0)
#define PG8_WAIT_V(n) asm volatile("s_waitcnt vmcnt(" #n ")" ::: "memory")
#define PG8_WAIT_L(n) asm volatile("s_waitcnt lgkmcnt(" #n ")" ::: "memory")
#define PG8_BAR __builtin_amdgcn_s_barrier()
#define PG8_SCHED __builtin_amdgcn_sched_barrier(0)
#define PG8_KLOOP(MMA_, KO_) \
        constexpr int KOFF_ = KO_; \
        _Pragma("unroll 1") \
        for (int t = 0; t < nt; t += 2) { \
            const bool last = (t == nt - 2); \
            const char* a1 = cA + (size_t)(t + 1) * kstep; \
            PG8_LDB(B0, 0, 0); PG8_LDB(B1, 0, 1); PG8_SCHED; PG8_LDA(At, 0, 0); PG8_STAGE_A2(PG8_SA(1, 1), a1); \
            if (last && has_next) PG8_SETOFF(nxt); \
            const char* a2 = last ? nA : cA + (size_t)(t + 2) * kstep; const char* b2 = last ? nB : cB + (size_t)(t + 2) * kstep; \
            const char* a3 = a2 + kstep; const char* b3 = b2 + kstep; \
            PG8_WAIT_V(8); PG8_WAIT_L(0); PG8_BAR; MMA_(0, 0, At, B0); MMA_(0, 1, At, B1); PG8_BAR; PG8_SCHED; \
            PG8_LDA(At, 0, 1); PG8_STAGE(PG8_SB(0, 0), b2, voffB); PG8_STAGE(PG8_SB(0, 1), b2 + hB, voffB); PG8_STAGE(PG8_SA(0, 0), a2, voffA); \
            PG8_WAIT_V(8); PG8_WAIT_L(0); PG8_BAR; MMA_(1, 0, At, B0); MMA_(1, 1, At, B1); PG8_BAR; PG8_SCHED; \
            PG8_LDB(B0, 1, 0); PG8_LDB(B1, 1, 1); PG8_SCHED; PG8_LDA(At, 1, 0); PG8_STAGE_A2(PG8_SA(0, 1), a2); \
            PG8_WAIT_V(8); PG8_WAIT_L(0); PG8_BAR; MMA_(0, 0, At, B0); MMA_(0, 1, At, B1); PG8_BAR; PG8_SCHED; \
            PG8_LDA(At, 1, 1); PG8_STAGE(PG8_SB(1, 0), b3, voffB); PG8_STAGE(PG8_SB(1, 1), b3 + hB, voffB); PG8_STAGE(PG8_SA(1, 0), a3, voffA); \
            PG8_WAIT_V(8); PG8_WAIT_L(0); PG8_BAR; MMA_(1, 0, At, B0); MMA_(1, 1, At, B1); PG8_BAR; PG8_SCHED; \
        }
    f32x4 acc[2][2][4][2];
#pragma unroll
    for (int a = 0; a < 2; ++a)
#pragma unroll
        for (int b = 0; b < 2; ++b)
#pragma unroll
            for (int m = 0; m < 4; ++m)
#pragma unroll
                for (int n = 0; n < 2; ++n) acc[a][b][m][n] = (f32x4){0.f, 0.f, 0.f, 0.f};
    bf16x8 At[4][2], B0[2][2], B1[2][2];
    const char* cA = cur.A; const char* cB = cur.B; int nt = cur.nt;
    PG8_STAGE(PG8_SB(0, 0), cB, voffB); PG8_STAGE(PG8_SB(0, 1), cB + hB, voffB); PG8_STAGE(PG8_SA(0, 0), cA, voffA); PG8_STAGE_A2(PG8_SA(0, 1), cA);
    if (wr == 1) PG8_BAR;
    PG8_WAIT_V(2); PG8_BAR;
    PG8_STAGE(PG8_SB(1, 0), cB + kstep, voffB); PG8_STAGE(PG8_SA(1, 0), cA + kstep, voffA); PG8_STAGE(PG8_SB(1, 1), cB + hB + kstep, voffB);
    PG8_WAIT_V(6); PG8_BAR;
    for (;;) {
        const bool has_next = S.next(ui + 1, nxt);
        const char* nA = has_next ? nxt.A : cA; const char* nB = has_next ? nxt.B : cB;
        if (MODE == 1 || (MODE == 2 && f8)) { PG8_KLOOP(PG8_MMA_F8, 16) } else { PG8_KLOOP(PG8_MMA_BF, 1024) }
        if (wr == 0) PG8_BAR;
        { int tid_ = tid; asm volatile("" : "+v"(tid_)); const int fr_ = tid_ & 15, fq_ = (tid_ >> 4) & 3; E(acc, cur, wr, wc, fr_, fq_, tid_); }
        if (!has_next) break;
#pragma unroll
        for (int a = 0; a < 2; ++a)
#pragma unroll
            for (int b = 0; b < 2; ++b)
#pragma unroll
                for (int m = 0; m < 4; ++m)
#pragma unroll
                    for (int n = 0; n < 2; ++n) acc[a][b][m][n] = (f32x4){0.f, 0.f, 0.f, 0.f};
        cur = nxt; cA = nA; cB = nB; nt = cur.nt; ++ui;
        if (MODE == 2) { f8 = cur.f8 != 0; PG8_SETFRAG(); }
        if (wr == 1) PG8_BAR;
    }
    PG8_WAIT_V(0);
    PG8_BAR;
#undef PG8_SETOFF
#undef PG8_SETFRAG
#undef PG8_SA
#undef PG8_SB
#undef PG8_STAGE
#undef PG8_STAGE_A2
#undef PG8_LDA
#undef PG8_LDB
#undef PG8_MMA_F8
#undef PG8_MMA_BF
#undef PG8_KLOOP
#undef PG8_PAIR
#undef PG8_WAIT_V
#undef PG8_WAIT_L
#undef PG8_BAR
#undef PG8_SCHED
}
}

typedef f32x4 acc_t[2][2][4][2];
__device__ __forceinline__ float sigmoid_f(float x) { return __builtin_amdgcn_rcpf(1.0f + __builtin_amdgcn_exp2f(-x * LOG2E)); }

struct EpiBf16 {
    static constexpr bool PERM = true;
    bf16_t* O; int ldc; float* kmsum; unsigned* kdone = nullptr; float osc = 1.0f;
    __device__ __forceinline__ void operator()(const acc_t& acc, const pg8::GU& u, int wr, int wc, int fr, int fq, int tid) const {
        const int row0 = u.pm * 256 + wr * 64 + fr, col0 = u.pn * 256 + wc * 32 + 8 * fq;
#pragma unroll
        for (int ai = 0; ai < 2; ++ai)
#pragma unroll
            for (int m = 0; m < 4; ++m) { bf16_t* rowp = O + (size_t)(row0 + ai * 128 + m * 16) * ldc + col0;
#pragma unroll
                for (int bj = 0; bj < 2; ++bj) { const f32x4 v0 = acc[ai][bj][m][0] * osc, v1 = acc[ai][bj][m][1] * osc;
                    u32x4 w; w.x = cvtpk(v0[0], v0[1]); w.y = cvtpk(v0[2], v0[3]); w.z = cvtpk(v1[0], v1[1]); w.w = cvtpk(v1[2], v1[3]);
                    *(u32x4*)(rowp + bj * 128) = w; } }
        if (kdone != nullptr && u.pn == 0) {
            asm volatile("s_waitcnt vmcnt(0)" ::: "memory");
            if (fq * 16 + fr == 0) (void)__hip_atomic_fetch_add(kdone, 1u, __ATOMIC_RELAXED, __HIP_MEMORY_SCOPE_AGENT);
        }
        if (kmsum != nullptr && u.pn == 1) {
#pragma unroll
            for (int bj = 0; bj < 2; ++bj)
#pragma unroll
                for (int n = 0; n < 2; ++n)
#pragma unroll
                    for (int j = 0; j < 4; ++j) {
                        float s = 0.f;
#pragma unroll
                        for (int ai = 0; ai < 2; ++ai)
#pragma unroll
                            for (int m = 0; m < 4; ++m) s += acc[ai][bj][m][n][j];
                        { const int ln = fq * 16 + fr; s += shflx(s, 1, ln); s += shflx(s, 2, ln); s += shflx(s, 4, ln); s += shflx(s, 8, ln); }
                        if (fr == 0) atomicAdd(kmsum + (size_t)u.pm * 256 + bj * 128 + wc * 32 + 8 * fq + 4 * n + j, s);
                    }
            asm volatile("s_waitcnt vmcnt(0)" ::: "memory");
            if (fq * 16 + fr == 0) (void)__hip_atomic_fetch_add(kdone, 1u, __ATOMIC_RELAXED, __HIP_MEMORY_SCOPE_AGENT);
        }
    }
};
struct EpiFp8 {
    static constexpr bool PERM = true;
    unsigned char* O; int ldc; float osc;
    __device__ __forceinline__ void operator()(const acc_t& acc, const pg8::GU& u, int wr, int wc, int fr, int fq, int tid) const {
        const int row0 = u.pm * 256 + wr * 64 + fr, col0 = u.pn * 256 + wc * 32 + 8 * fq;
#pragma unroll
        for (int ai = 0; ai < 2; ++ai)
#pragma unroll
            for (int m = 0; m < 4; ++m) { unsigned char* rowp = O + (size_t)(row0 + ai * 128 + m * 16) * ldc + col0;
#pragma unroll
                for (int bj = 0; bj < 2; ++bj) { const f32x4 v0 = acc[ai][bj][m][0] * osc, v1 = acc[ai][bj][m][1] * osc;
                    u32x2 w; w.x = pk_fp8x4(v0[0], v0[1], v0[2], v0[3]); w.y = pk_fp8x4(v1[0], v1[1], v1[2], v1[3]);
                    *(u32x2*)(rowp + bj * 128) = w; } }
    }
};
template <bool INF32>
struct EpiResid {
    static constexpr bool PERM = true;
    const float* xin32; const bf16_t* xin16; bf16_t* xout;
    __device__ __forceinline__ void operator()(const acc_t& acc, const pg8::GU& u, int wr, int wc, int fr, int fq, int tid) const {
        const int row0 = u.pm * 256 + wr * 64 + fr, col0 = u.pn * 256 + wc * 32 + 8 * fq;
#pragma unroll
        for (int ai = 0; ai < 2; ++ai)
#pragma unroll
            for (int m = 0; m < 4; ++m) { const size_t off = (size_t)(row0 + ai * 128 + m * 16) * DM + col0;
#pragma unroll
                for (int bj = 0; bj < 2; ++bj) { f32x4 v0 = acc[ai][bj][m][0], v1 = acc[ai][bj][m][1];
                    if (INF32) { v0 += *(const f32x4*)(xin32 + off + bj * 128); v1 += *(const f32x4*)(xin32 + off + bj * 128 + 4); }
                    else { const u32x4 b = *(const u32x4*)(xin16 + off + bj * 128);
                        v0[0] += bf_lo(b.x); v0[1] += bf_hi(b.x); v0[2] += bf_lo(b.y); v0[3] += bf_hi(b.y); v1[0] += bf_lo(b.z); v1[1] += bf_hi(b.z); v1[2] += bf_lo(b.w); v1[3] += bf_hi(b.w); }
                    u32x4 w; w.x = cvtpk(v0[0], v0[1]); w.y = cvtpk(v0[2], v0[3]); w.z = cvtpk(v1[0], v1[1]); w.w = cvtpk(v1[2], v1[3]);
                    *(u32x4*)(xout + off + bj * 128) = w; } }
    }
};
constexpr float GSC = 1.0f / 32.0f;
__device__ __forceinline__ float sigmoid_g(float acc) { return __builtin_amdgcn_rcpf(1.0f + __builtin_amdgcn_exp2f(acc * (-GSC * LOG2E))); }
struct EpiGate {
    static constexpr bool PERM = true;
    bf16_t* merged; unsigned char* sscr;
    __device__ __forceinline__ void operator()(const acc_t& acc, const pg8::GU& u, int wr, int wc, int fr, int fq, int tid) const {
        if ((u.aux & 1) == 0) {
#pragma unroll
            for (int ai = 0; ai < 2; ++ai)
#pragma unroll
                for (int bj = 0; bj < 2; ++bj)
#pragma unroll
                    for (int m = 0; m < 4; ++m) { const f32x4 v0 = acc[ai][bj][m][0], v1 = acc[ai][bj][m][1];
                        u32x4 w; w.x = cvtpk(sigmoid_g(v0[0]), sigmoid_g(v0[1])); w.y = cvtpk(sigmoid_g(v0[2]), sigmoid_g(v0[3])); w.z = cvtpk(sigmoid_g(v1[0]), sigmoid_g(v1[1])); w.w = cvtpk(sigmoid_g(v1[2]), sigmoid_g(v1[3]));
                        *(u32x4*)(sscr + ((size_t)(((ai * 2 + bj) * 4 + m) * 512 + tid)) * 16) = w; asm volatile("" ::: "memory"); }
        } else {
            const bool first = (u.aux >> 1) == 0;
            const int row0 = u.pm * 256 + wr * 64 + fr, col0 = u.pn * 256 + wc * 32 + 8 * fq;
            u32x4 sv[2][2][4];
            u32x4 ov[4][2];
#pragma unroll
            for (int ai = 0; ai < 2; ++ai)
#pragma unroll
                for (int bj = 0; bj < 2; ++bj)
#pragma unroll
                    for (int m = 0; m < 4; ++m) sv[ai][bj][m] = *(const u32x4*)(sscr + ((size_t)(((ai * 2 + bj) * 4 + m) * 512 + tid)) * 16);
            if (!first) {
#pragma unroll
                for (int m = 0; m < 4; ++m)
#pragma unroll
                    for (int bj = 0; bj < 2; ++bj) ov[m][bj] = *(const u32x4*)(merged + (size_t)(row0 + m * 16) * DM + col0 + bj * 128);
            }
#pragma unroll
            for (int ai = 0; ai < 2; ++ai) {
                asm volatile("" ::: "memory");
#pragma unroll
                for (int m = 0; m < 4; ++m) { bf16_t* rowp = merged + (size_t)(row0 + ai * 128 + m * 16) * DM + col0;
#pragma unroll
                    for (int bj = 0; bj < 2; ++bj) {
                        const u32x4 sq = sv[ai][bj][m];
                        const f32x4 v0 = acc[ai][bj][m][0], v1 = acc[ai][bj][m][1];
                        float r[8] = {bf_lo(sq.x) * v0[0], bf_hi(sq.x) * v0[1], bf_lo(sq.y) * v0[2], bf_hi(sq.y) * v0[3], bf_lo(sq.z) * v1[0], bf_hi(sq.z) * v1[1], bf_lo(sq.w) * v1[2], bf_hi(sq.w) * v1[3]};
                        if (!first) { const u32x4 o = ov[m][bj];
                            r[0] += bf_lo(o.x); r[1] += bf_hi(o.x); r[2] += bf_lo(o.y); r[3] += bf_hi(o.y); r[4] += bf_lo(o.z); r[5] += bf_hi(o.z); r[6] += bf_lo(o.w); r[7] += bf_hi(o.w); }
                        u32x4 w; w.x = cvtpk(r[0], r[1]); w.y = cvtpk(r[2], r[3]); w.z = cvtpk(r[4], r[5]); w.w = cvtpk(r[6], r[7]);
                        *(u32x4*)(rowp + bj * 128) = w; } }
                asm volatile("" ::: "memory");
                if (ai == 0 && !first) {
#pragma unroll
                    for (int m = 0; m < 4; ++m)
#pragma unroll
                        for (int bj = 0; bj < 2; ++bj) ov[m][bj] = *(const u32x4*)(merged + (size_t)(row0 + 128 + m * 16) * DM + col0 + bj * 128);
                }
            }
        }
    }
};
struct EpiSilu {
    static constexpr bool PERM = true;
    unsigned char* H; float isc; unsigned* hdone;
    __device__ __forceinline__ void operator()(const acc_t& acc, const pg8::GU& u, int wr, int wc, int fr, int fq, int tid) const {
        const int row0 = u.pm * 256 + wr * 64 + fr, col0 = u.pn * 128 + wc * 32 + 8 * fq;
#pragma unroll
        for (int ai = 0; ai < 2; ++ai)
#pragma unroll
            for (int m = 0; m < 4; ++m) { unsigned char* rowp = H + (size_t)(row0 + ai * 128 + m * 16) * DEXP + col0;
                float r[8];
#pragma unroll
                for (int n = 0; n < 2; ++n)
#pragma unroll
                    for (int j = 0; j < 4; ++j) { const float a = acc[ai][0][m][n][j] * isc, g = acc[ai][1][m][n][j] * isc; r[4 * n + j] = a * sigmoid_f(a) * g; }
                u32x2 w; w.x = pk_fp8x4(r[0], r[1], r[2], r[3]); w.y = pk_fp8x4(r[4], r[5], r[6], r[7]);
                __hip_atomic_store((unsigned long long*)rowp, ((unsigned long long)w.y << 32) | (unsigned long long)w.x, __ATOMIC_RELAXED, __HIP_MEMORY_SCOPE_AGENT); }
        asm volatile("s_waitcnt vmcnt(0)" ::: "memory");
        if (fq * 16 + fr == 0) (void)__hip_atomic_fetch_add(hdone + u.pm, 1u, __ATOMIC_RELAXED, __HIP_MEMORY_SCOPE_AGENT);
    }
};

struct SchedProj { static constexpr bool GATHER = false; static constexpr int AUXA = 0; const char* A; const char* B; int G, c;
    __device__ __forceinline__ bool next(int i, pg8::GU& u) const { int pm, pn; const long L = (long)i * G + c;
        if (!pg8::linear_tile(NTOK / 256, INC / 256, L, pm, pn)) return false;
        u.A = A + (size_t)pm * 256 * 2048; u.B = B + (size_t)pn * 256 * 2048; u.pa = 2048; u.pb = 2048; u.nt = 16; u.pm = pm; u.pn = pn; u.aux = 0; u.f8 = 0; return true; } };
struct SchedWo { static constexpr bool GATHER = false; static constexpr int AUXA = 0; const char* A; const char* B; int G, c;
    __device__ __forceinline__ bool next(int i, pg8::GU& u) const { int pm, pn; if (!pg8::static_tile(NTOK / 256, 4, G, c, i, pm, pn)) return false;
        u.A = A + (size_t)pm * 256 * 2048; u.B = B + (size_t)pn * 256 * 2048; u.pa = 2048; u.pb = 2048; u.nt = 16; u.pm = pm; u.pn = pn; u.aux = 0; u.f8 = 0; return true; } };
struct SchedGate { static constexpr bool GATHER = false; static constexpr int AUXA = 0; const char* Hh; const char* Oo; const char* Wg; const char* Wbr; int G, c;
    __device__ __forceinline__ bool next(int i, pg8::GU& u) const { int pm, pn; if (!pg8::static_tile(NTOK / 256, 4, G, c, i >> 3, pm, pn)) return false;
        const int sub = i & 7, br = sub >> 1; u.pm = pm; u.pn = pn; u.aux = sub;
        if ((sub & 1) == 0) { u.A = Hh + (size_t)pm * 256 * 1024; u.B = Wg + (size_t)(br * 1024 + pn * 256) * 1024; u.pa = 1024; u.pb = 1024; u.nt = 8; u.f8 = 1; }
        else { u.A = Oo + (size_t)pm * 256 * 2048 + br * 512; u.B = Wbr + (size_t)(br * 1024 + pn * 256) * 512; u.pa = 2048; u.pb = 512; u.nt = 4; u.f8 = 0; }
        return true; } };
constexpr int LDS_MOE = 131072;
constexpr int MOE_LIST_CAP = NTOK;
template <unsigned PA, unsigned PB, int NT, bool GATHER_>
struct SchedMoe { static constexpr bool GATHER = GATHER_; static constexpr int AUXA = GATHER_ ? 0 : 17;
    ldsp lds; const char* A; const char* B; int G, c; const unsigned* lists; unsigned* hdone;
    __device__ __forceinline__ bool next(int i, pg8::GU& u) const { const LAS int* tb = (const LAS int*)(lds + LDS_MOE); const int T = __builtin_amdgcn_readfirstlane(tb[0]);
        int uu = c + i * G;
        if (!GATHER_) { const int U = 4 * T, full = U / G, rem = U - full * G, nl = G - rem;
            if (i >= full) { if (c < rem) return false; const int j = (c - rem) + (i - full) * nl; if (j >= rem) return false; uu = full * G + j; } }
        if (uu >= 4 * T) return false;
        const int tile = uu >> 2, pn = uu & 3, e = __builtin_amdgcn_readfirstlane(tb[1 + tile]);
        u.B = B + (size_t)(e * 1024 + pn * 256) * PB; u.pa = PA; u.pb = PB; u.nt = NT; u.pm = tile; u.pn = pn; u.aux = 0; u.f8 = 0;
        if (GATHER_) { const int first = __builtin_amdgcn_readfirstlane(tb[400 + e]), cnt = __builtin_amdgcn_readfirstlane(tb[440 + e]), r0 = tile * 256 - first;
            u.A = A; u.rows = lists + (size_t)e * MOE_LIST_CAP + r0; u.nrows = cnt - r0 < 256 ? cnt - r0 : 256; }
        else { u.A = A + (size_t)tile * 256 * PA; u.rows = nullptr; u.nrows = 0;
            unsigned sp = 0u; while (__hip_atomic_load(hdone + tile, __ATOMIC_RELAXED, __HIP_MEMORY_SCOPE_AGENT) < 32u) { __builtin_amdgcn_s_sleep(2); if (++sp > (1u << 24)) break; }
            }
        return true; } };

struct CvItem { const float* W; int N; unsigned char* dst; int K; float scale; int f8; };
__device__ __forceinline__ void cv_load(const CvItem& c, float (&wv)[32], int lane) {
#pragma unroll
    for (int i = 0; i < 32; ++i) { const int kk = 2 * i + (lane >> 5); wv[i] = c.W[(size_t)kk * c.N + (lane & 31)]; }
}
__device__ __forceinline__ void cv_store(const CvItem& c, const float (&wv)[32], LAS float* scr, int lane) {
#pragma unroll
    for (int i = 0; i < 32; ++i) { const int kk = 2 * i + (lane >> 5); scr[kk * 33 + (lane & 31)] = wv[i] * c.scale; }
    LDS_WAIT(); asm volatile("" ::: "memory");
    if (c.f8) {
        const int n = lane >> 1;
#pragma unroll
        for (int j = 0; j < 2; ++j) { const int cc = (lane & 1) * 2 + j; const LAS float* s = scr + (16 * cc) * 33 + n;
            u32x4 o; o.x = pk_fp8x4(s[0 * 33], s[1 * 33], s[2 * 33], s[3 * 33]); o.y = pk_fp8x4(s[4 * 33], s[5 * 33], s[6 * 33], s[7 * 33]);
            o.z = pk_fp8x4(s[8 * 33], s[9 * 33], s[10 * 33], s[11 * 33]); o.w = pk_fp8x4(s[12 * 33], s[13 * 33], s[14 * 33], s[15 * 33]);
            *(u32x4*)(c.dst + (size_t)n * c.K + 16 * cc) = o; }
    } else {
        const int cc = lane & 7;
#pragma unroll
        for (int j = 0; j < 4; ++j) { const int n = (lane >> 3) + 8 * j; const LAS float* s = scr + (8 * cc) * 33 + n;
            u32x4 o; o.x = cvtpk(s[0 * 33], s[1 * 33]); o.y = cvtpk(s[2 * 33], s[3 * 33]); o.z = cvtpk(s[4 * 33], s[5 * 33]); o.w = cvtpk(s[6 * 33], s[7 * 33]);
            *(u32x4*)(c.dst + ((size_t)n * c.K + 8 * cc) * 2) = o; }
    }
    LDS_WAIT(); asm volatile("" ::: "memory");
}
__device__ __forceinline__ void ph_convert(const Frame& F, int l) {
    LAS float* scr = (LAS float*)(F.lds + F.wave * 16384);
    const int gw = F.bid * 8 + F.wave, NGW = F.G * 8;
    const float* w_in = F.in[3] + (size_t)l * DM * INC; const float* w_gate = F.in[10] + (size_t)l * 4 * DM * DM; const float* w_br = F.in[11] + (size_t)l * 4 * 256 * DM;
    const float* w_o = F.in[12] + (size_t)l * DM * DM; const float* w1 = F.in[18] + (size_t)l * NEXP * DM * DEXP; const float* w3 = F.in[19] + (size_t)l * NEXP * DM * DEXP; const float* w2 = F.in[20] + (size_t)l * NEXP * DEXP * DM;
    unsigned char* win_t = F.ws + WS_WIN; unsigned char* wg_t = F.ws + WS_WG; unsigned char* wbr_t = F.ws + WS_WBR; unsigned char* wo_t = F.ws + WS_WO;
    unsigned char* w13_t = F.ws + WS_W13; unsigned char* w2_t = F.ws + WS_W2;
    constexpr int I_IN = 16 * 88, I_G = 4 * 16 * 32, I_BR = 4 * 4 * 32, I_O = 16 * 32, I_1 = NEXP * 16 * 16, I_2 = NEXP * 8 * 32;
    constexpr int NITEMS = I_IN + I_G + I_BR + I_O + 2 * I_1 + I_2;
#define CV_DECODE(it_, c_) do { int r = (it_); \
        if (r < I_IN) { const int kb = r / 88, nb = r % 88, n0 = nb * 32, ct = n0 >> 8; \
            c_.scale = (ct == 0 || ct == 6 || ct == 9) ? 0.125f * LOG2E : (ct == 3 ? 0.17677669529663687f * LOG2E : 1.0f);     \
            c_.W = w_in + (size_t)(kb * 64) * INC + n0; c_.N = INC; c_.dst = win_t + ((size_t)n0 * DM + kb * 64) * 2; c_.K = DM; c_.f8 = 0; break; } r -= I_IN; \
        if (r < I_G) { const int i = r / 512, q = r % 512, kb = q / 32, nb = q % 32; \
            c_.W = w_gate + (size_t)i * DM * DM + (size_t)(kb * 64) * DM + nb * 32; c_.N = DM; c_.dst = wg_t + (size_t)(i * 1024 + nb * 32) * DM + kb * 64; c_.K = DM; c_.scale = 32.0f; c_.f8 = 1; break; } r -= I_G; \
        if (r < I_BR) { const int i = r / 128, q = r % 128, kb = q / 32, nb = q % 32; \
            c_.W = w_br + (size_t)i * 256 * DM + (size_t)(kb * 64) * DM + nb * 32; c_.N = DM; c_.dst = wbr_t + ((size_t)(i * 1024 + nb * 32) * 256 + kb * 64) * 2; c_.K = 256; c_.scale = 1.0f; c_.f8 = 0; break; } r -= I_BR; \
        if (r < I_O) { const int kb = r / 32, nb = r % 32; \
            c_.W = w_o + (size_t)(kb * 64) * DM + nb * 32; c_.N = DM; c_.dst = wo_t + ((size_t)(nb * 32) * DM + kb * 64) * 2; c_.K = DM; c_.scale = 1.0f; c_.f8 = 0; break; } r -= I_O; \
        if (r < 2 * I_1) { const int which = r / I_1, q = r % I_1, e = q / 256, qq = q % 256, kb = qq / 16, nb = qq % 16, n0 = nb * 32; \
            const int drow = e * 1024 + (n0 >> 7) * 256 + (n0 & 127) + which * 128; \
            c_.W = (which ? w3 : w1) + (size_t)e * DM * DEXP + (size_t)(kb * 64) * DEXP + n0; c_.N = DEXP; c_.dst = w13_t + (size_t)drow * DM + kb * 64; c_.K = DM; c_.scale = 32.0f; c_.f8 = 1; break; } r -= 2 * I_1; \
        { const int e = r / 256, qq = r % 256, kb = qq / 32, nb = qq % 32; \
            c_.W = w2 + (size_t)e * DEXP * DM + (size_t)(kb * 64) * DM + nb * 32; c_.N = DM; c_.dst = w2_t + (size_t)(e * 1024 + nb * 32) * DEXP + kb * 64; c_.K = DEXP; c_.scale = 16.0f; c_.f8 = 1; } } while (0)
    if (gw >= NITEMS) return;
    CvItem cur, nxt; float wv[32], wn[32];
    CV_DECODE(gw, cur); cv_load(cur, wv, F.lane);
    for (int it = gw; it < NITEMS; it += NGW) {
        const bool more = it + NGW < NITEMS;
        if (more) { CV_DECODE(it + NGW, nxt); cv_load(nxt, wn, F.lane); }
        cv_store(cur, wv, scr, F.lane);
        if (more) { cur = nxt;
#pragma unroll
            for (int i = 0; i < 32; ++i) wv[i] = wn[i]; }
    }
#undef CV_DECODE
}
__device__ __forceinline__ float lam_init_of(int l) { return l == 0 ? 0.2f : 0.35550906f; }
__device__ __forceinline__ void ph_lam(const Frame& F) {
    if (F.bid == 0 && F.wave == 0) {
        for (int l = 0; l < DEPTH; ++l) {
            float a = 0.f, b = 0.f;
            if (F.lane < 32) { a = F.in[4][l * 32 + F.lane] * F.in[5][l * 32 + F.lane]; b = F.in[6][l * 32 + F.lane] * F.in[7][l * 32 + F.lane]; }
            a = wave_sum(a, F.lane); b = wave_sum(b, F.lane);
            if (F.lane == 0) F.ctl[CW_LAM + l] = __float_as_uint(__expf(a) - __expf(b) + lam_init_of(l));
        }
    }
}
__device__ __forceinline__ void ph_norm(const Frame& F, const float* x, const float* g, bf16_t* h, unsigned char* h8) {
    const int gw = F.bid * 8 + F.wave, NGW = F.G * 8;
    f32x4 gv[4];
#pragma unroll
    for (int j = 0; j < 4; ++j) gv[j] = *(const f32x4*)(g + 4 * F.lane + 256 * j);
    for (int m = gw; m < NTOK; m += NGW) {
        const f32x4* xr = (const f32x4*)(x + (size_t)m * DM) + F.lane;
        f32x4 v[4]; float s = 0.f;
#pragma unroll
        for (int j = 0; j < 4; ++j) { v[j] = xr[64 * j]; s += (v[j].x * v[j].x + v[j].y * v[j].y) + (v[j].z * v[j].z + v[j].w * v[j].w); }
        const float rstd = 1.0f / sqrtf(wave_sum(s, F.lane) * (1.0f / DM) + NORM_EPS);
        u32x2* o8 = (u32x2*)(h + (size_t)m * DM) + F.lane;
        unsigned* o4 = (unsigned*)(h8 + (size_t)m * DM) + F.lane;
#pragma unroll
        for (int j = 0; j < 4; ++j) { const f32x4 y = v[j] * rstd * gv[j]; u32x2 w; w.x = cvtpk(y.x, y.y); w.y = cvtpk(y.z, y.w); o8[64 * j] = w; o4[64 * j] = pk_fp8x4(y.x, y.y, y.z, y.w); }
    }
}
constexpr int R_LD = 1028;
constexpr int R_WG = 0, R_WE = 4 * R_LD * 4, R_BIAS = R_WE + 32 * R_LD * 4;
__device__ __forceinline__ void ph_route(const Frame& F, int l, const bf16_t* x2, unsigned char* h2, unsigned* tok, unsigned* lists) {
    const float* wrg = F.in[14] + (size_t)l * DM * 4; const float* brg = F.in[15] + l * 4; const float* wre = F.in[16] + (size_t)l * DM * NEXP; const float* bre = F.in[17] + l * NEXP;
    const float* g = F.in[13] + (size_t)l * DM;
    LAS float* Lg = (LAS float*)(F.lds + R_WG); LAS float* Le = (LAS float*)(F.lds + R_WE); LAS float* Lb = (LAS float*)(F.lds + R_BIAS);
    {
        f32x4 wv[2 + 16];
#pragma unroll
        for (int i = 0; i < 2; ++i) wv[i] = *(const f32x4*)(wrg + 4 * (F.tid + 512 * i));
#pragma unroll
        for (int i = 0; i < 16; ++i) wv[2 + i] = *(const f32x4*)(wre + 4 * (F.tid + 512 * i));
#pragma unroll
        for (int i = 0; i < 2; ++i) { const int c = F.tid + 512 * i; Lg[0 * R_LD + c] = wv[i].x; Lg[1 * R_LD + c] = wv[i].y; Lg[2 * R_LD + c] = wv[i].z; Lg[3 * R_LD + c] = wv[i].w; }
#pragma unroll
        for (int i = 0; i < 16; ++i) { const int idx = 4 * (F.tid + 512 * i), c = idx >> 5, j = idx & 31; Le[(j + 0) * R_LD + c] = wv[2 + i].x; Le[(j + 1) * R_LD + c] = wv[2 + i].y; Le[(j + 2) * R_LD + c] = wv[2 + i].z; Le[(j + 3) * R_LD + c] = wv[2 + i].w; }
    }
    if (F.tid < 4) Lb[F.tid] = brg[F.tid]; else if (F.tid < 36) Lb[F.tid] = bre[F.tid - 4];
    __syncthreads();
    unsigned* cnt = F.ctl + CW_CNT + l * 32 * 64;
    const int gw = F.bid * 8 + F.wave, NGW = F.G * 8;
    f32x4 gv[4];
#pragma unroll
    for (int j = 0; j < 4; ++j) gv[j] = *(const f32x4*)(g + 4 * F.lane + 256 * j);
    f32x4 wgr[4][4];
#pragma unroll
    for (int q = 0; q < 4; ++q)
#pragma unroll
        for (int j = 0; j < 4; ++j) wgr[q][j] = *(const LAS f32x4*)(Lg + q * R_LD + 4 * F.lane + 256 * j);
    u32x2 xn[4];
    if (gw < NTOK) { const u32x2* xr0 = (const u32x2*)(x2 + (size_t)gw * DM) + F.lane;
#pragma unroll
        for (int j = 0; j < 4; ++j) xn[j] = xr0[64 * j]; }
    int pm_ = -1; unsigned pea = 0u, peb = 0u, ppa = 0u, ppb = 0u; float pg0 = 0.f, pg1 = 0.f;
#define ROUTE_RETIRE() do { if (pm_ >= 0 && F.lane == 0) { u32x4 t; t.x = (pea << 24) | ppa; t.y = (peb << 24) | ppb; t.z = __float_as_uint(pg0); t.w = __float_as_uint(pg1); \
            *(u32x4*)(tok + (size_t)pm_ * 4) = t; lists[(size_t)pea * MOE_LIST_CAP + ppa] = (unsigned)pm_; lists[(size_t)peb * MOE_LIST_CAP + ppb] = (unsigned)pm_; } } while (0)
    for (int m = gw; m < NTOK; m += NGW) {
        f32x4 v[4]; float s = 0.f;
#pragma unroll
        for (int j = 0; j < 4; ++j) { const u32x2 xw = xn[j]; v[j].x = bf_lo(xw.x); v[j].y = bf_hi(xw.x); v[j].z = bf_lo(xw.y); v[j].w = bf_hi(xw.y); s += (v[j].x * v[j].x + v[j].y * v[j].y) + (v[j].z * v[j].z + v[j].w * v[j].w); }
        if (m + NGW < NTOK) { const u32x2* xr1 = (const u32x2*)(x2 + (size_t)(m + NGW) * DM) + F.lane;
#pragma unroll
            for (int j = 0; j < 4; ++j) xn[j] = xr1[64 * j]; }
        const float rstd = 1.0f / sqrtf(wave_sum(s, F.lane) * (1.0f / DM) + NORM_EPS);
        unsigned* o4 = (unsigned*)(h2 + (size_t)m * DM) + F.lane;
#pragma unroll
        for (int j = 0; j < 4; ++j) { v[j] = v[j] * rstd * gv[j]; o4[64 * j] = pk_fp8x4(v[j].x, v[j].y, v[j].z, v[j].w); }
        float gl[4];
#pragma unroll
        for (int q = 0; q < 4; ++q) { float a = 0.f;
#pragma unroll
            for (int j = 0; j < 4; ++j) { const f32x4 w = wgr[q][j]; a += (v[j].x * w.x + v[j].y * w.y) + (v[j].z * w.z + v[j].w * w.w); }
            gl[q] = wave_sum(a, F.lane) + Lb[q]; }
        int grp = 0; float gmax = gl[0];
#pragma unroll
        for (int q = 1; q < 4; ++q) if (gl[q] > gmax) { gmax = gl[q]; grp = q; }
        float den = 0.f;
#pragma unroll
        for (int q = 0; q < 4; ++q) den += __expf(gl[q] - gmax);
        const float pgrp = 1.0f / den;
        grp = __builtin_amdgcn_readfirstlane(grp);
        float el[8];
#pragma unroll
        for (int q = 0; q < 8; ++q) { float a = 0.f; const LAS float* wrow = Le + (grp * 8 + q) * R_LD + 4 * F.lane;
#pragma unroll
            for (int j = 0; j < 4; ++j) { const f32x4 w = *(const LAS f32x4*)(wrow + 256 * j); a += (v[j].x * w.x + v[j].y * w.y) + (v[j].z * w.z + v[j].w * w.w); }
            el[q] = wave_sum(a, F.lane) + Lb[4 + grp * 8 + q]; }
        int i0 = 0; float v0 = el[0];
#pragma unroll
        for (int q = 1; q < 8; ++q) if (el[q] > v0) { v0 = el[q]; i0 = q; }
        int i1 = -1; float v1 = -INFINITY;
#pragma unroll
        for (int q = 0; q < 8; ++q) if (q != i0 && el[q] > v1) { v1 = el[q]; i1 = q; }
        const float e1 = __expf(v1 - v0), g0 = pgrp / (1.0f + e1), g1 = pgrp * e1 / (1.0f + e1);
        ROUTE_RETIRE();
        pea = (unsigned)(grp * 8 + i0); peb = (unsigned)(grp * 8 + i1); pg0 = g0; pg1 = g1; pm_ = m;
        if (F.lane == 0) {
            ppa = __hip_atomic_fetch_add(cnt + pea * 64, 1u, __ATOMIC_RELAXED, __HIP_MEMORY_SCOPE_AGENT);
            ppb = __hip_atomic_fetch_add(cnt + peb * 64, 1u, __ATOMIC_RELAXED, __HIP_MEMORY_SCOPE_AGENT);
        }
    }
    ROUTE_RETIRE();
#undef ROUTE_RETIRE
}
__device__ __forceinline__ void moe_tables(const Frame& F, int l) {
    LAS int* tb = (LAS int*)(F.lds + LDS_MOE);
    if (F.tid < NEXP) tb[440 + F.tid] = (int)__hip_atomic_load(F.ctl + CW_CNT + l * 32 * 64 + F.tid * 64, __ATOMIC_RELAXED, __HIP_MEMORY_SCOPE_AGENT);
    __syncthreads();
    if (F.tid < NEXP) {
        int t = 0;
        for (int e = 0; e < F.tid; ++e) t += (tb[440 + e] + 255) >> 8;
        const int nt = (tb[440 + F.tid] + 255) >> 8;
        tb[400 + F.tid] = t * 256;
        for (int k = 0; k < nt; ++k) tb[1 + t + k] = F.tid;
        if (F.tid == NEXP - 1) tb[0] = t + nt;
    }
    __syncthreads();
}
__device__ __forceinline__ void ph_combine(const Frame& F, int l, const bf16_t* x2, const unsigned char* y, const unsigned* tok, const float* g, float* xfinal, bf16_t* xout, bf16_t* h, unsigned char* h8, bool final_) {
    moe_tables(F, l);
    const LAS int* tb = (const LAS int*)(F.lds + LDS_MOE);
    const int gw = F.bid * 8 + F.wave, NGW = F.G * 8;
    f32x4 gv[4];
#pragma unroll
    for (int j = 0; j < 4; ++j) gv[j] = *(const f32x4*)(g + 4 * F.lane + 256 * j);
    u32x4 tk1 = (u32x4){0u, 0u, 0u, 0u}, tk2 = tk1;
    u32x2 xw0[4], xw1[4]; unsigned ya0[4], yb0[4], ya1[4], yb1[4]; float g00 = 0.f, g10 = 0.f, g01 = 0.f, g11 = 0.f;
#define FIN_ISSUE(mrow, tk_, xw_, ya_, yb_, ga_, gb_) do { u32x4 t_ = tk_; \
        t_.x = (unsigned)tb[400 + (t_.x >> 24)] + (t_.x & 0xffffffu); t_.y = (unsigned)tb[400 + (t_.y >> 24)] + (t_.y & 0xffffffu);     \
        ga_ = __uint_as_float(t_.z) * 0.125f; gb_ = __uint_as_float(t_.w) * 0.125f;     \
        const u32x2* xr_ = (const u32x2*)(x2 + (size_t)(mrow) * DM) + F.lane; \
        const unsigned* y0_ = (const unsigned*)(y + (size_t)t_.x * DM) + F.lane; const unsigned* y1_ = (const unsigned*)(y + (size_t)t_.y * DM) + F.lane; \
        _Pragma("unroll") for (int j = 0; j < 4; ++j) { xw_[j] = xr_[64 * j]; ya_[j] = y0_[64 * j]; yb_[j] = y1_[64 * j]; } } while (0)
    if (gw < NTOK) { tk1 = *(const u32x4*)(tok + (size_t)gw * 4); FIN_ISSUE(gw, tk1, xw1, ya1, yb1, g01, g11); }
    if (gw + NGW < NTOK) tk1 = *(const u32x4*)(tok + (size_t)(gw + NGW) * 4);
    for (int m = gw; m < NTOK; m += NGW) {
#pragma unroll
        for (int j = 0; j < 4; ++j) { xw0[j] = xw1[j]; ya0[j] = ya1[j]; yb0[j] = yb1[j]; }
        g00 = g01; g10 = g11;
        if (m + 2 * NGW < NTOK) tk2 = *(const u32x4*)(tok + (size_t)(m + 2 * NGW) * 4);
        if (m + NGW < NTOK) FIN_ISSUE(m + NGW, tk1, xw1, ya1, yb1, g01, g11);
        tk1 = tk2;
        const float g0 = g00, g1 = g10;
        f32x4 v[4]; float s = 0.f;
#pragma unroll
        for (int j = 0; j < 4; ++j) { const u32x2 xw = xw0[j]; v[j].x = bf_lo(xw.x); v[j].y = bf_hi(xw.x); v[j].z = bf_lo(xw.y); v[j].w = bf_hi(xw.y); const unsigned a = ya0[j], b = yb0[j];
            const f32x2_t a0 = __builtin_amdgcn_cvt_pk_f32_fp8((int)a, false), a1 = __builtin_amdgcn_cvt_pk_f32_fp8((int)a, true), b0 = __builtin_amdgcn_cvt_pk_f32_fp8((int)b, false), b1 = __builtin_amdgcn_cvt_pk_f32_fp8((int)b, true);
            v[j].x += g0 * a0.x + g1 * b0.x; v[j].y += g0 * a0.y + g1 * b0.y; v[j].z += g0 * a1.x + g1 * b1.x; v[j].w += g0 * a1.y + g1 * b1.y;
            s += (v[j].x * v[j].x + v[j].y * v[j].y) + (v[j].z * v[j].z + v[j].w * v[j].w); }
        const float rstd = 1.0f / sqrtf(wave_sum(s, F.lane) * (1.0f / DM) + NORM_EPS);
        if (final_) {
            f32x4* xo = (f32x4*)(xfinal + (size_t)m * DM) + F.lane;
#pragma unroll
            for (int j = 0; j < 4; ++j) xo[64 * j] = v[j] * rstd * gv[j];
        } else {
            u32x2* xo = (u32x2*)(xout + (size_t)m * DM) + F.lane;
            u32x2* o8 = (u32x2*)(h + (size_t)m * DM) + F.lane;
            unsigned* o4 = (unsigned*)(h8 + (size_t)m * DM) + F.lane;
#pragma unroll
            for (int j = 0; j < 4; ++j) { u32x2 xw; xw.x = cvtpk(v[j].x, v[j].y); xw.y = cvtpk(v[j].z, v[j].w); xo[64 * j] = xw; const f32x4 y = v[j] * rstd * gv[j]; u32x2 w; w.x = cvtpk(y.x, y.y); w.y = cvtpk(y.z, y.w); o8[64 * j] = w; o4[64 * j] = pk_fp8x4(y.x, y.y, y.z, y.w); }
        }
    }
#undef FIN_ISSUE
}
namespace att {
constexpr int A_KV = 0  , A_OST = 65536, A_WSF = 131072, A_TAB = 133120, A_KM = 139264, A_MISC = 147456  ;
#define BAR_L() asm volatile("s_waitcnt lgkmcnt(0)\n\ts_barrier" ::: "memory")
#define WAIT_BAR(N) asm volatile("s_waitcnt vmcnt(" #N ") lgkmcnt(0)\n\ts_barrier" ::: "memory")
__device__ __forceinline__ void glds16(const void* gsrc, unsigned lds_dst) { unsigned keep;
    asm volatile("s_mov_b32 %0, m0\n\ts_mov_b32 m0, %2\n\ts_nop 0\n\tglobal_load_lds_dwordx4 %1, off\n\ts_mov_b32 m0, %0" : "=&s"(keep) : "v"(gsrc), "s"(lds_dst) : "memory"); }
constexpr float NEG_BIG = -1.0e30f;
__device__ __forceinline__ int crow(int r, int hi) { return (r & 3) + 8 * (r >> 2) + 4 * hi; }
__device__ __forceinline__ s16x4 vtr(ldsp p) { return __builtin_bit_cast(s16x4, __builtin_amdgcn_ds_read_tr16_b64_v4i16((LAS s16x4*)p)); }
__device__ __forceinline__ float swapmax(float m) { auto rr = __builtin_amdgcn_permlane32_swap(__float_as_uint(m), __float_as_uint(m), false, false); return fmaxf(__uint_as_float(rr[0]), __uint_as_float(rr[1])); }
__device__ __forceinline__ float swapsum(float m) { auto rr = __builtin_amdgcn_permlane32_swap(__float_as_uint(m), __float_as_uint(m), false, false); return __uint_as_float(rr[0]) + __uint_as_float(rr[1]); }

struct Ctx { ldsp lds; const bf16_t* proj; bf16_t* o; int tid, lane, wid, r32, hi, shadow; };
#ifndef DPROBE
#define DPROBE 0
#endif

__device__ __forceinline__ int rel_bucket(int n) { if (n < 16) return n; int v = 16 + (int)(__logf((float)n / 16.0f) / 2.0794415416798357f * 16.0f); return v > 31 ? 31 : v; }
__device__ __forceinline__ void build_tables(const Ctx& c, const float* rel_bias) {
    LAS float* tab = (LAS float*)(c.lds + A_TAB);
    for (int idx = c.tid; idx < 12 * 128; idx += 512) { const int h = idx >> 7, i = idx & 127; float v = rel_bias[rel_bucket(i) * 12 + h]; if (h < 8) v -= rel_bias[31 * 12 + h]; tab[idx] = v * LOG2E; }
}
__device__ __forceinline__ void glds16s(const void* sbase_, unsigned voff, unsigned lds_dst) { unsigned keep;
    const unsigned long long pk_ = (unsigned long long)sbase_; const void* sbase = (const void*)(((unsigned long long)(unsigned)__builtin_amdgcn_readfirstlane((int)(pk_ >> 32)) << 32) | (unsigned)__builtin_amdgcn_readfirstlane((int)pk_));
    asm volatile("s_mov_b32 %0, m0\n\ts_mov_b32 m0, %3\n\ts_nop 0\n\tglobal_load_lds_dwordx4 %1, %2\n\ts_mov_b32 m0, %0" : "=&s"(keep) : "v"(voff), "s"(sbase), "s"(lds_dst) : "memory"); }
template <bool DIFF>
__device__ __forceinline__ void stage_kv(const Ctx& c, int slot, long krow0, int kcol, int kcol2, int vcol) {
    const unsigned base = (unsigned)(uintptr_t)c.lds + A_KV + slot * 16384 + c.wid * 1024;
    const int kc = DIFF ? (c.wid < 4 ? kcol + c.wid * 8 : kcol2 + (c.wid - 4) * 8) : kcol + c.wid * 8;
    const bf16_t* kb = c.proj + (size_t)krow0 * INC + kc;
    const bf16_t* vb = c.proj + (size_t)(krow0 + 16 * (c.wid & 3)) * INC + vcol + (c.wid >> 2) * 32;
    glds16s(kb, (unsigned)c.lane * (INC * 2), (unsigned)__builtin_amdgcn_readfirstlane(base));
    glds16s(vb, (unsigned)(c.lane >> 2) * (INC * 2) + (unsigned)(c.lane & 3) * 16u, (unsigned)__builtin_amdgcn_readfirstlane(base + 8192));
}
struct KVB { unsigned long long k, v; };
__device__ __forceinline__ unsigned long long uni64(const void* p) { const unsigned long long q = (unsigned long long)p; return ((unsigned long long)(unsigned)__builtin_amdgcn_readfirstlane((int)(q >> 32)) << 32) | (unsigned)__builtin_amdgcn_readfirstlane((int)q); }
template <bool DIFF>
__device__ __forceinline__ KVB kv_base(const Ctx& c, long rowbase, int kcol, int kcol2, int vcol) {
    const int kc = DIFF ? (c.wid < 4 ? kcol + c.wid * 8 : kcol2 + (c.wid - 4) * 8) : kcol + c.wid * 8;
    KVB b; b.k = uni64(c.proj + (size_t)rowbase * INC + kc); b.v = uni64(c.proj + (size_t)(rowbase + 16 * (c.wid & 3)) * INC + vcol + (c.wid >> 2) * 32); return b;
}
__device__ __forceinline__ void stage_kvb(const Ctx& c, int slot, const KVB& b, int trow  ) {
    const unsigned base = (unsigned)(uintptr_t)c.lds + A_KV + slot * 16384 + c.wid * 1024;
    const unsigned off = (unsigned)__builtin_amdgcn_readfirstlane(trow) * (unsigned)(INC * 2);
    glds16s((const void*)(b.k + off), (unsigned)c.lane * (INC * 2), (unsigned)__builtin_amdgcn_readfirstlane(base));
    glds16s((const void*)(b.v + off), (unsigned)(c.lane >> 2) * (INC * 2) + (unsigned)(c.lane & 3) * 16u, (unsigned)__builtin_amdgcn_readfirstlane(base + 8192));
}
__device__ __forceinline__ bf16x8 kone_frag(int hi) { u32x4 w; w.x = hi == 0 ? 0x3F80u : 0u; w.y = 0u; w.z = 0u; w.w = 0u; return __builtin_bit_cast(bf16x8, w); }
__device__ __forceinline__ unsigned qx_frag(float m, int hi) { return hi == 0 ? (cvtpk(-m, 0.f) & 0xffffu) : 0u; }
__device__ __forceinline__ float bf_round(float x) { return bf_lo(cvtpk(x, 0.f)); }
template <int ND, bool FOLD>
__device__ __forceinline__ void qk_tile(f32x16& p0, f32x16& p1, ldsp kslot, const bf16x8* qf, int r32, int hi, unsigned qxw = 0u) {
    ldsp kb = kslot + hi * 1024 + r32 * 16;
    bf16x8 b0[ND], b1[ND];
#pragma unroll
    for (int d0 = 0; d0 < ND; ++d0) { b0[d0] = *(const LAS bf16x8*)(kb + d0 * 2048); b1[d0] = *(const LAS bf16x8*)(kb + d0 * 2048 + 512); }
    __builtin_amdgcn_sched_barrier(0);
    p0 = (f32x16){}; p1 = (f32x16){};
    if (FOLD) { const bf16x8 k1 = kone_frag(hi); u32x4 qw; qw.x = qxw; qw.y = 0u; qw.z = 0u; qw.w = 0u; const bf16x8 qx = __builtin_bit_cast(bf16x8, qw); p0 = __builtin_amdgcn_mfma_f32_32x32x16_bf16(k1, qx, p0, 0, 0, 0); p1 = __builtin_amdgcn_mfma_f32_32x32x16_bf16(k1, qx, p1, 0, 0, 0); }
#pragma unroll
    for (int d0 = 0; d0 < ND; ++d0) {
        p0 = __builtin_amdgcn_mfma_f32_32x32x16_bf16(b0[d0], qf[d0], p0, 0, 0, 0);
        p1 = __builtin_amdgcn_mfma_f32_32x32x16_bf16(b1[d0], qf[d0], p1, 0, 0, 0);
    }
    __builtin_amdgcn_sched_barrier(0);
}
__device__ __forceinline__ void pack_p(const f32x16& p0, const f32x16& p1, bf16x8 (&pa)[4]) {
    u32x4 w;
    w.x = cvtpk(p0[0], p0[1]); w.y = cvtpk(p0[2], p0[3]); w.z = cvtpk(p0[4], p0[5]); w.w = cvtpk(p0[6], p0[7]); pa[0] = __builtin_bit_cast(bf16x8, w);
    w.x = cvtpk(p0[8], p0[9]); w.y = cvtpk(p0[10], p0[11]); w.z = cvtpk(p0[12], p0[13]); w.w = cvtpk(p0[14], p0[15]); pa[1] = __builtin_bit_cast(bf16x8, w);
    w.x = cvtpk(p1[0], p1[1]); w.y = cvtpk(p1[2], p1[3]); w.z = cvtpk(p1[4], p1[5]); w.w = cvtpk(p1[6], p1[7]); pa[2] = __builtin_bit_cast(bf16x8, w);
    w.x = cvtpk(p1[8], p1[9]); w.y = cvtpk(p1[10], p1[11]); w.z = cvtpk(p1[12], p1[13]); w.w = cvtpk(p1[14], p1[15]); pa[3] = __builtin_bit_cast(bf16x8, w);
}
template <int NM>
__device__ __forceinline__ void pv_tile(f32x16 (&oa)[2], f32x16 (&ob)[2], ldsp vslot, const bf16x8 (&pa)[4], const bf16x8 (&pb)[4], int lane, int hi) {
    ldsp vb = vslot + ((lane >> 4) & 1) * 32 + (lane & 3) * 8 + (4 * hi + ((lane & 15) >> 2)) * 64;
#pragma unroll
    for (int d0 = 0; d0 < 2; ++d0) {
        s16x4 lo[4], hh[4];
#pragma unroll
        for (int ks = 0; ks < 4; ++ks) { lo[ks] = vtr(vb + d0 * 4096 + ks * 1024); hh[ks] = vtr(vb + d0 * 4096 + ks * 1024 + 512); }
        __builtin_amdgcn_sched_barrier(0);
#pragma unroll
        for (int ks = 0; ks < 4; ++ks) {
            const bf16x8 vf = (bf16x8){lo[ks][0], lo[ks][1], lo[ks][2], lo[ks][3], hh[ks][0], hh[ks][1], hh[ks][2], hh[ks][3]};
            oa[d0] = __builtin_amdgcn_mfma_f32_32x32x16_bf16(pa[ks], vf, oa[d0], 0, 0, 0);
            if (NM == 2) ob[d0] = __builtin_amdgcn_mfma_f32_32x32x16_bf16(pb[ks], vf, ob[d0], 0, 0, 0);
        }
        __builtin_amdgcn_sched_barrier(0);
    }
}
__device__ __forceinline__ void mask_bias(f32x16& p0, f32x16& p1, int dbase, int hi, const LAS float* tab, bool lookup, int tmax, bool causal, bool window, bool rowoff) {
#pragma unroll
    for (int r = 0; r < 16; ++r) {
        const int d0 = dbase - crow(r, hi), d1 = d0 - 32;
        if (lookup) { const int i0 = d0 < 0 ? 0 : (d0 > tmax ? tmax : d0), i1 = d1 < 0 ? 0 : (d1 > tmax ? tmax : d1); p0[r] += tab[i0]; p1[r] += tab[i1]; }
        if (causal) { if (d0 < 0) p0[r] = -INFINITY; if (d1 < 0) p1[r] = -INFINITY; }
        if (window) { if (d0 >= 128) p0[r] = -INFINITY; if (d1 >= 128) p1[r] = -INFINITY; }
        if (rowoff) { p0[r] = -INFINITY; p1[r] = -INFINITY; }
    }
}
__device__ __forceinline__ float max3f(float a, float b, float c) { float r; asm("v_max3_f32 %0, %1, %2, %3" : "=v"(r) : "v"(a), "v"(b), "v"(c)); return r; }
__device__ __forceinline__ void softmax_tile(f32x16& p0, f32x16& p1, float& m, float& l, f32x16 (&o)[2], LAS float* wsf, int r32, int hi, bf16x8 (&pa)[4], unsigned& qx) {
    float ra = max3f(p0[0], p1[0], p0[1]), rb = max3f(p0[4], p1[4], p0[5]), rc = max3f(p0[8], p1[8], p0[9]), rd = max3f(p0[12], p1[12], p0[13]);
    ra = max3f(ra, p1[1], p0[2]); rb = max3f(rb, p1[5], p0[6]); rc = max3f(rc, p1[9], p0[10]); rd = max3f(rd, p1[13], p0[14]);
    ra = max3f(ra, p1[2], p0[3]); rb = max3f(rb, p1[6], p0[7]); rc = max3f(rc, p1[10], p0[11]); rd = max3f(rd, p1[14], p0[15]);
    ra = max3f(ra, p1[3], rb); rc = max3f(rc, p1[7], rd);
    float rm = max3f(ra, rc, p1[11]); rm = max3f(rm, p1[15], p1[15]);
    rm = swapmax(rm);
    const bool upd = (rm > 0.f) || (l == 0.f && rm > -INFINITY);
    if (__any(upd)) {
        const float mn = upd ? bf_round(m + rm) : m, delta = mn - m;
        const float f = (l == 0.f) ? 1.0f : __builtin_amdgcn_exp2f(-delta);
        l *= f;
        if (hi == 0) wsf[r32] = f;
        LDS_WAIT();
#pragma unroll
        for (int r = 0; r < 16; ++r) { const float fr = wsf[crow(r, hi)]; o[0][r] *= fr; o[1][r] *= fr; p0[r] -= delta; p1[r] -= delta; }
        LDS_WAIT();
        m = mn; qx = qx_frag(m, hi);
    }
    f32x16 e0, e1; float s0 = 0.f, s1 = 0.f;
#pragma unroll
    for (int r = 0; r < 16; ++r) { e0[r] = __builtin_amdgcn_exp2f(p0[r]); e1[r] = __builtin_amdgcn_exp2f(p1[r]); s0 += e0[r]; s1 += e1[r]; }
    l += s0 + s1;
    pack_p(e0, e1, pa);
}
__device__ __forceinline__ void softmax_fast(const f32x16& p0, const f32x16& p1, float& l, bf16x8 (&pa)[4]) {
    f32x16 e0, e1; float s0 = 0.f, s1 = 0.f;
#pragma unroll
    for (int r = 0; r < 16; ++r) { e0[r] = __builtin_amdgcn_exp2f(p0[r]); e1[r] = __builtin_amdgcn_exp2f(p1[r]); s0 += e0[r]; s1 += e1[r]; }
    l += s0 + s1;
    pack_p(e0, e1, pa);
}
__device__ __forceinline__ bool acc_in_range(float lsum, const f32x16 (&o)[2]) {
    bool ok = (lsum > 0.f) && (lsum < INFINITY);
#pragma unroll
    for (int r = 0; r < 16; ++r) ok = ok && (fabsf(o[0][r]) < INFINITY) && (fabsf(o[1][r]) < INFINITY);
    return ok;
}
__device__ __forceinline__ void stage_o(LAS float* stg, const f32x16 (&o)[2], const float (&rs)[16], int r32, int hi) {
#pragma unroll
    for (int r = 0; r < 16; ++r) { const int q = crow(r, hi); stg[q * 64 + r32] = o[0][r] * rs[r]; stg[q * 64 + 32 + r32] = o[1][r] * rs[r]; }
}
template <bool RMS>
__device__ __forceinline__ void store_o(const LAS float* stg, bf16_t* dst  , int lane, const float* gain, float outscale) {
    LDS_WAIT();
    const int ch = lane & 7;
    float g8[8];
#pragma unroll
    for (int j = 0; j < 8; ++j) g8[j] = RMS ? gain[ch * 8 + j] * outscale : 1.0f;
#pragma unroll
    for (int i = 0; i < 4; ++i) { const int row = i * 8 + (lane >> 3);
        const f32x4 a = *(const LAS f32x4*)(stg + row * 64 + ch * 8), b = *(const LAS f32x4*)(stg + row * 64 + ch * 8 + 4);
        float v[8] = {a.x, a.y, a.z, a.w, b.x, b.y, b.z, b.w};
        if (RMS) { float ss = 0.f;
#pragma unroll
            for (int j = 0; j < 8; ++j) ss += v[j] * v[j];
            ss += shflx(ss, 1, lane); ss += shflx(ss, 2, lane); ss += shflx(ss, 4, lane);
            const float rstd = 1.0f / sqrtf(ss * (1.0f / 64.0f) + NORM_EPS);
#pragma unroll
            for (int j = 0; j < 8; ++j) v[j] = v[j] * rstd * g8[j]; }
        u32x4 w; w.x = cvtpk(v[0], v[1]); w.y = cvtpk(v[2], v[3]); w.z = cvtpk(v[4], v[5]); w.w = cvtpk(v[6], v[7]);
        *(u32x4*)(dst + (size_t)row * DM + ch * 8) = w; }
    LDS_WAIT();
}
__device__ __forceinline__ void load_q(const Ctx& c, bf16x8* qf, long qrow, int col, int nd) {
    for (int d0 = 0; d0 < nd; ++d0) qf[d0] = *(const bf16x8*)(c.proj + (size_t)qrow * INC + col + d0 * 16 + c.hi * 8);
}

__device__ __forceinline__ float tile_rowmax(const f32x16& p0, const f32x16& p1) {
    float ra = max3f(p0[0], p1[0], p0[1]), rb = max3f(p0[4], p1[4], p0[5]), rc = max3f(p0[8], p1[8], p0[9]), rd = max3f(p0[12], p1[12], p0[13]);
    ra = max3f(ra, p1[1], p0[2]); rb = max3f(rb, p1[5], p0[6]); rc = max3f(rc, p1[9], p0[10]); rd = max3f(rd, p1[13], p0[14]);
    ra = max3f(ra, p1[2], p0[3]); rb = max3f(rb, p1[6], p0[7]); rc = max3f(rc, p1[10], p0[11]); rd = max3f(rd, p1[14], p0[15]);
    ra = max3f(ra, p1[3], rb); rc = max3f(rc, p1[7], rd);
    float rm = max3f(ra, rc, p1[11]); rm = max3f(rm, p1[15], p1[15]);
    return swapmax(rm);
}
__device__ __forceinline__ float tile_update(f32x16& p0, f32x16& p1, float rm, float& m, float& l, unsigned& qx, int hi) {
    const bool upd = (rm > 0.f) || (l == 0.f && rm > -INFINITY);
    const float mn = upd ? bf_round(m + rm) : m, delta = mn - m;
    const float f = (l == 0.f) ? 1.0f : __builtin_amdgcn_exp2f(-delta);
    l *= f;
#pragma unroll
    for (int r = 0; r < 16; ++r) { p0[r] -= delta; p1[r] -= delta; }
    m = mn; qx = qx_frag(m, hi);
    return f;
}
__device__ __forceinline__ void o_rescale(f32x16 (&o)[2], float f, LAS float* wsf, int r32, int hi) {
    if (hi == 0) wsf[r32] = f;
    LDS_WAIT();
#pragma unroll
    for (int r = 0; r < 16; ++r) { const float fr = wsf[crow(r, hi)]; o[0][r] *= fr; o[1][r] *= fr; }
    LDS_WAIT();
}
template <bool ODD>
__device__ __forceinline__ void pv_exp_map(f32x16 (&o)[2], ldsp vslot, bf16x8 (&P)[4], const f32x16& p0, const f32x16& p1, float& l, int lane, int hi) {
    ldsp vb = vslot + ((lane >> 4) & 1) * 32 + (lane & 3) * 8 + (4 * hi + ((lane & 15) >> 2)) * 64;
    float s0 = 0.f, s1 = 0.f; unsigned wa[4], wb[4];
#pragma unroll
    for (int ks = 0; ks < 4; ++ks) {
        const int slot = ODD ? ((ks == 1) ? 2 : (ks == 2) ? 1 : ks) : ks;
        const s16x4 l0 = vtr(vb + ks * 1024), h0 = vtr(vb + ks * 1024 + 512), l1 = vtr(vb + 4096 + ks * 1024), h1 = vtr(vb + 4096 + ks * 1024 + 512);
        const bf16x8 v0 = (bf16x8){l0[0], l0[1], l0[2], l0[3], h0[0], h0[1], h0[2], h0[3]}, v1 = (bf16x8){l1[0], l1[1], l1[2], l1[3], h1[0], h1[1], h1[2], h1[3]};
        o[0] = __builtin_amdgcn_mfma_f32_32x32x16_bf16(P[slot], v0, o[0], 0, 0, 0);
        o[1] = __builtin_amdgcn_mfma_f32_32x32x16_bf16(P[slot], v1, o[1], 0, 0, 0);
        const int g = 4 * ks;
        const float a0 = __builtin_amdgcn_exp2f(p0[g]), a1 = __builtin_amdgcn_exp2f(p0[g + 1]), a2 = __builtin_amdgcn_exp2f(p0[g + 2]), a3 = __builtin_amdgcn_exp2f(p0[g + 3]);
        const float b0 = __builtin_amdgcn_exp2f(p1[g]), b1 = __builtin_amdgcn_exp2f(p1[g + 1]), b2 = __builtin_amdgcn_exp2f(p1[g + 2]), b3 = __builtin_amdgcn_exp2f(p1[g + 3]);
        s0 += (a0 + a1) + (a2 + a3); s1 += (b0 + b1) + (b2 + b3);
        wa[2 * (ks & 1)] = cvtpk(a0, a1); wa[2 * (ks & 1) + 1] = cvtpk(a2, a3); wb[2 * (ks & 1)] = cvtpk(b0, b1); wb[2 * (ks & 1) + 1] = cvtpk(b2, b3);
        if (ks & 1) {
            const int sprev = ODD ? ((ks == 1) ? 0 : 1) : ks - 1;
            u32x4 qa, qb; qa.x = wa[0]; qa.y = wa[1]; qa.z = wa[2]; qa.w = wa[3]; qb.x = wb[0]; qb.y = wb[1]; qb.z = wb[2]; qb.w = wb[3];
            P[sprev] = __builtin_bit_cast(bf16x8, qa); P[slot] = __builtin_bit_cast(bf16x8, qb);
        }
    }
    l += s0 + s1;
}
#define DIFF_PFR(P, ODD_, k) ((ODD_) ? P[((k) == 1) ? 2 : ((k) == 2) ? 1 : (k)] : P[(k)])
template <bool SAFE>
__device__ __forceinline__ void diff_core(const Ctx& c, long rowbase, int h, int qb, ldsp qlds, float& l1, float& l2, f32x16 (&o1)[2], f32x16 (&o2)[2]) {
    const int q0 = qb * 256, qmin = q0 + 32 * c.wid, qabs = qmin + c.r32;
#define DIFF_QK(NX) do { bf16x8 qa_[2], qb_[2]; qa_[0] = *(const LAS bf16x8*)(qlds); qa_[1] = *(const LAS bf16x8*)(qlds + 16); qb_[0] = *(const LAS bf16x8*)(qlds + 32); qb_[1] = *(const LAS bf16x8*)(qlds + 48); \
        qk_tile<2, SAFE>(sa0, sa1, (NX), qa_, c.r32, c.hi, qx1); qk_tile<2, SAFE>(sb0, sb1, (NX) + 4096, qb_, c.r32, c.hi, qx2); } while (0)
    float m1 = 0.f, m2 = 0.f; unsigned qx1 = 0u, qx2 = 0u; l1 = 0.f; l2 = 0.f; o1[0] = (f32x16){}; o1[1] = (f32x16){}; o2[0] = (f32x16){}; o2[1] = (f32x16){};
    LAS float* wsf = (LAS float*)(c.lds + A_WSF) + c.wid * 64; const LAS float* tab = (const LAS float*)(c.lds + A_TAB) + (4 + h) * 128;
    const int NT = 4 * (qb + 1);
    const KVB kvb = kv_base<true>(c, rowbase, CB_K1 + h * 32, CB_K2 + h * 32, CB_V + h * 64);
    VM_WAIT();
#pragma unroll
    for (int j = 0; j < 4; ++j) stage_kvb(c, j, kvb, 64 * j);
    WAIT_BAR(0);
    f32x16 sa0, sa1, sb0, sb1; bf16x8 P1[4], P2[4];
#pragma unroll
    for (int i = 0; i < 4; ++i) { P1[i] = bf16x8{}; P2[i] = bf16x8{}; }
    DIFF_QK(c.lds + A_KV);
    int sl = 0;
#define DIFF_MAP(ODD_, S0, S1, M_, L_, QX_, O_, P_, DB_) do { \
        if (act && (causal || lookup)) mask_bias(S0, S1, DB_, c.hi, tab, lookup, 113, causal, false, false); \
        if (SAFE) { const float rm = tile_rowmax(S0, S1); float f = 1.0f; const bool u = __any((rm > 0.f) || (L_ == 0.f && rm > -INFINITY)) != 0; \
            if (u) f = tile_update(S0, S1, rm, M_, L_, QX_, c.hi); \
            pv_exp_map<ODD_>(O_, vprev, P_, S0, S1, L_, c.lane, c.hi); \
            if (u) o_rescale(O_, f, wsf, c.r32, c.hi); } \
        else pv_exp_map<ODD_>(O_, vprev, P_, S0, S1, L_, c.lane, c.hi); } while (0)
#define DIFF_ITER(t, ODD_) do { \
        const int k0 = 64 * (t); const bool act = (k0 <= qmin + 31), actp = ((t) == 0) || (k0 - 64 <= qmin + 31); \
        if ((t) + 4 < NT) stage_kvb(c, sl >= 2 ? sl - 2 : sl + 4, kvb, 64 * ((t) + 4)); \
        const int slp = ((t) == 0) ? 0 : (sl == 0 ? 5 : sl - 1), sln = sl == 5 ? 0 : sl + 1; \
        ldsp vprev = c.lds + A_KV + slp * 16384 + 8192; \
        if (actp) {     \
            const bool causal = (k0 + 63 > qmin), lookup = act && (qmin - (k0 + 63) < 113); \
            if (!act) { _Pragma("unroll") for (int r_ = 0; r_ < 16; ++r_) { sa0[r_] = -INFINITY; sa1[r_] = -INFINITY; sb0[r_] = -INFINITY; sb1[r_] = -INFINITY; } } \
            DIFF_MAP(ODD_, sa0, sa1, m1, l1, qx1, o1, P1, qabs - k0); \
            { int db2 = qabs - k0; asm volatile("" : "+v"(db2)); DIFF_MAP(ODD_, sb0, sb1, m2, l2, qx2, o2, P2, db2); } \
        } \
        if ((t) + 1 < NT && k0 + 64 <= qmin + 31) { ldsp nx = c.lds + A_KV + sln * 16384; DIFF_QK(nx); } \
        if ((t) + 4 < NT) WAIT_BAR(4); else if ((t) + 3 < NT) WAIT_BAR(2); else WAIT_BAR(0); \
        sl = sln; } while (0)
#pragma unroll 1
    for (int t = 0; t < NT; t += 2) {
        DIFF_ITER(t, false);
        DIFF_ITER(t + 1, true);
    }
#undef DIFF_ITER
#undef DIFF_MAP
#undef DIFF_QK
    if (64 * (NT - 1) <= qmin + 31) pv_tile<2>(o1, o2, c.lds + A_KV + (sl == 0 ? 5 : sl - 1) * 16384 + 8192, P1, P2, c.lane, c.hi);
    BAR_L();
}
struct DFrag { s16x4 l0, h0, l1, h1; bf16x8 kf; };
template <int KS>
__device__ __forceinline__ void diff_read(DFrag& f, ldsp vb, ldsp kb) {
    f.l0 = vtr(vb + KS * 1024); f.h0 = vtr(vb + KS * 1024 + 512); f.l1 = vtr(vb + 4096 + KS * 1024); f.h1 = vtr(vb + 4096 + KS * 1024 + 512);
    f.kf = *(const LAS bf16x8*)(kb + (KS >> 1) * 2048 + (KS & 1) * 512);
}
template <int KS, bool NEXT>
__device__ __forceinline__ void diff_step(f32x16 (&o)[2], bf16x8 (&P)[4], const f32x16& s0, const f32x16& s1, float& l, f32x16& n0, f32x16& n1, const bf16x8 (&qf)[2], const DFrag& cur, DFrag& nxt, ldsp vbn, ldsp kbn) {
    constexpr int g = 8 * (KS & 1);
    const f32x16& src = (KS < 2) ? s0 : s1;
    if (NEXT) diff_read<(KS + 1) & 3>(nxt, vbn, kbn);
    const bf16x8 v0 = (bf16x8){cur.l0[0], cur.l0[1], cur.l0[2], cur.l0[3], cur.h0[0], cur.h0[1], cur.h0[2], cur.h0[3]}, v1 = (bf16x8){cur.l1[0], cur.l1[1], cur.l1[2], cur.l1[3], cur.h1[0], cur.h1[1], cur.h1[2], cur.h1[3]};
    o[0] = __builtin_amdgcn_mfma_f32_32x32x16_bf16(P[KS], v0, o[0], 0, 0, 0);
    __builtin_amdgcn_sched_barrier(0);
    float e0 = __builtin_amdgcn_exp2f(src[g]), e1 = __builtin_amdgcn_exp2f(src[g + 1]), e2 = __builtin_amdgcn_exp2f(src[g + 2]), e3 = __builtin_amdgcn_exp2f(src[g + 3]);
    asm volatile("" : "+v"(e0), "+v"(e1), "+v"(e2), "+v"(e3));
    __builtin_amdgcn_sched_barrier(0);
    o[1] = __builtin_amdgcn_mfma_f32_32x32x16_bf16(P[KS], v1, o[1], 0, 0, 0);
    __builtin_amdgcn_sched_barrier(0);
    float c0 = e0 + e1; c0 += e2; c0 += e3;
    float e4 = __builtin_amdgcn_exp2f(src[g + 4]), e5 = __builtin_amdgcn_exp2f(src[g + 5]), e6 = __builtin_amdgcn_exp2f(src[g + 6]), e7 = __builtin_amdgcn_exp2f(src[g + 7]);
    u32x4 w; w.x = cvtpk(e0, e1); w.y = cvtpk(e2, e3);
    asm volatile("" : "+v"(e4), "+v"(e5), "+v"(e6), "+v"(e7), "+v"(w.x), "+v"(w.y), "+v"(c0));
    __builtin_amdgcn_sched_barrier(0);
    if ((KS & 1) == 0) n0 = __builtin_amdgcn_mfma_f32_32x32x16_bf16(cur.kf, qf[KS >> 1], (KS < 2) ? (f32x16){} : n0, 0, 0, 0);
    else               n1 = __builtin_amdgcn_mfma_f32_32x32x16_bf16(cur.kf, qf[KS >> 1], (KS < 2) ? (f32x16){} : n1, 0, 0, 0);
    __builtin_amdgcn_sched_barrier(0);
    float c1 = e4 + e5; c1 += e6; c1 += e7;
    w.z = cvtpk(e4, e5); w.w = cvtpk(e6, e7);
    l += c0; l += c1;
    P[KS] = __builtin_bit_cast(bf16x8, w);
    asm volatile("" : "+v"(P[KS]), "+v"(l));
    __builtin_amdgcn_sched_barrier(0);
}
__device__ __forceinline__ void diff_fast(const Ctx& c, long rowbase, int h, int qb_, ldsp qlds, float& l1, float& l2, f32x16 (&o1)[2], f32x16 (&o2)[2]) {
    const int qb = __builtin_amdgcn_readfirstlane(qb_);
    const int q0 = qb * 256, qmin = __builtin_amdgcn_readfirstlane(q0 + 32 * c.wid), qabs = qmin + c.r32;
    l1 = 0.f; l2 = 0.f; o1[0] = (f32x16){}; o1[1] = (f32x16){}; o2[0] = (f32x16){}; o2[1] = (f32x16){};
    const LAS float* tab = (const LAS float*)(c.lds + A_TAB) + (4 + h) * 128;
    const int NT = 4 * (qb + 1);
    const KVB kvb = kv_base<true>(c, rowbase, CB_K1 + h * 32, CB_K2 + h * 32, CB_V + h * 64);
    WAIT_BAR(0);
    f32x16 sa0, sa1, sb0, sb1; bf16x8 P1[4], P2[4];
#pragma unroll
    for (int i = 0; i < 4; ++i) { P1[i] = bf16x8{}; P2[i] = bf16x8{}; }
    { bf16x8 qa_[2]; qa_[0] = *(const LAS bf16x8*)(qlds); qa_[1] = *(const LAS bf16x8*)(qlds + 16); qk_tile<2, false>(sa0, sa1, c.lds + A_KV, qa_, c.r32, c.hi); }
#define DIFF_TILE(T_, SLP_, SL_, SLN_) do { \
        const int k0 = 64 * (T_); const bool act = (k0 <= qmin + 31), actp = ((T_) == 0) || (k0 - 64 <= qmin + 31); \
        if (actp) {     \
            ldsp vb = c.lds + A_KV + (SLP_) * 16384 + 8192 + ((c.lane >> 4) & 1) * 32 + (c.lane & 3) * 8 + (4 * c.hi + ((c.lane & 15) >> 2)) * 64; \
            ldsp kb2 = c.lds + A_KV + (SL_) * 16384 + 4096 + c.hi * 1024 + c.r32 * 16, kb1 = c.lds + A_KV + (SLN_) * 16384 + c.hi * 1024 + c.r32 * 16; \
            DFrag f0, f1; \
            diff_read<0>(f0, vb, kb2); \
            const bool causal = (k0 + 63 > qmin), lookup = act && (qmin - (k0 + 63) < 113); \
            if (!act) { \
                _Pragma("unroll") for (int r_ = 0; r_ < 16; ++r_) { sa0[r_] = -INFINITY; sa1[r_] = -INFINITY; } \
            } else if (causal || lookup) mask_bias(sa0, sa1, qabs - k0, c.hi, tab, lookup, 113, causal, false, false); \
            { bf16x8 qb_[2]; qb_[0] = *(const LAS bf16x8*)(qlds + 32); qb_[1] = *(const LAS bf16x8*)(qlds + 48); \
              diff_step<0, true>(o1, P1, sa0, sa1, l1, sb0, sb1, qb_, f0, f1, vb, kb2); diff_step<1, true>(o1, P1, sa0, sa1, l1, sb0, sb1, qb_, f1, f0, vb, kb2); \
              diff_step<2, true>(o1, P1, sa0, sa1, l1, sb0, sb1, qb_, f0, f1, vb, kb2); diff_step<3, true>(o1, P1, sa0, sa1, l1, sb0, sb1, qb_, f1, f0, vb, kb1); } \
            if (!act) { \
                _Pragma("unroll") for (int r_ = 0; r_ < 16; ++r_) { sb0[r_] = -INFINITY; sb1[r_] = -INFINITY; } \
            } else if (causal || lookup) { int db2 = qabs - k0; asm volatile("" : "+v"(db2)); mask_bias(sb0, sb1, db2, c.hi, tab, lookup, 113, causal, false, false); } \
            { bf16x8 qa_[2]; qa_[0] = *(const LAS bf16x8*)(qlds); qa_[1] = *(const LAS bf16x8*)(qlds + 16); \
              diff_step<0, true>(o2, P2, sb0, sb1, l2, sa0, sa1, qa_, f0, f1, vb, kb1); diff_step<1, true>(o2, P2, sb0, sb1, l2, sa0, sa1, qa_, f1, f0, vb, kb1); \
              diff_step<2, true>(o2, P2, sb0, sb1, l2, sa0, sa1, qa_, f0, f1, vb, kb1); diff_step<3, false>(o2, P2, sb0, sb1, l2, sa0, sa1, qa_, f1, f0, vb, kb1); } \
        } } while (0)
    int sl = 0;
#pragma unroll 1
    for (int t = 0; t < NT; t += 2) {
        const int s2 = sl == 4 ? 0 : sl + 2, s3 = sl >= 3 ? sl - 3 : sl + 3, s4 = sl >= 2 ? sl - 2 : sl + 4, sm1 = sl == 0 ? 5 : sl - 1;
        if (t + 3 < NT) stage_kvb(c, s3, kvb, 64 * (t + 3));
        if (t + 4 < NT) stage_kvb(c, s4, kvb, 64 * (t + 4));
        DIFF_TILE(t, (t == 0 ? 0 : sm1), sl, sl + 1);
        DIFF_TILE(t + 1, sl, sl + 1, s2);
        WAIT_BAR(0);
        sl = s2;
    }
#undef DIFF_TILE
    if (64 * (NT - 1) <= qmin + 31) pv_tile<2>(o1, o2, c.lds + A_KV + (sl == 0 ? 5 : sl - 1) * 16384 + 8192, P1, P2, c.lane, c.hi);
    BAR_L();
}
__device__ __forceinline__ void diff_unit(const Ctx& c, int b, int h, int qb, float lam, const float* subln, float outscale) {
    const long rowbase = (long)b * SEQ; const int q0 = qb * 256, qmin = q0 + 32 * c.wid, qabs = qmin + c.r32;
    LAS unsigned* misc = (LAS unsigned*)(c.lds + A_MISC);
    if (c.tid == 0) misc[2] = 0u;
    { const KVB kvb0 = kv_base<true>(c, rowbase, CB_K1 + h * 32, CB_K2 + h * 32, CB_V + h * 64);
#pragma unroll
      for (int j = 0; j < 3; ++j) stage_kvb(c, j, kvb0, 64 * j); }
    {
        bf16x8 q1f[2], q2f[2];
#pragma unroll
        for (int d0 = 0; d0 < 2; ++d0) { q1f[d0] = *(const bf16x8*)(c.proj + (size_t)(rowbase + qabs) * INC + CB_Q1 + h * 32 + d0 * 16 + c.hi * 8); q2f[d0] = *(const bf16x8*)(c.proj + (size_t)(rowbase + qabs) * INC + CB_Q2 + h * 32 + d0 * 16 + c.hi * 8); }
        ldsp ql = c.lds + A_OST + 32768 + c.wid * 4096 + c.lane * 64;
        *(LAS bf16x8*)(ql) = q1f[0]; *(LAS bf16x8*)(ql + 16) = q1f[1]; *(LAS bf16x8*)(ql + 32) = q2f[0]; *(LAS bf16x8*)(ql + 48) = q2f[1];
        asm volatile("s_waitcnt vmcnt(0) lgkmcnt(0)" ::: "memory");
    }
    ldsp qlds = c.lds + A_OST + 32768 + c.wid * 4096 + c.lane * 64;
    float l1, l2; f32x16 o1[2], o2[2];
    diff_fast(c, rowbase, h, qb, qlds, l1, l2, o1, o2);
    l1 = swapsum(l1); l2 = swapsum(l2);
    {
        bool ok = (l1 > 0.f) && (l1 < INFINITY) && (l2 > 0.f) && (l2 < INFINITY);
#pragma unroll
        for (int r = 0; r < 16; ++r) ok = ok && (fabsf(o1[0][r]) < INFINITY) && (fabsf(o1[1][r]) < INFINITY) && (fabsf(o2[0][r]) < INFINITY) && (fabsf(o2[1][r]) < INFINITY);
        if (__any(!ok) && c.lane == 0) __hip_atomic_fetch_or(misc + 2, 1u, __ATOMIC_RELAXED, __HIP_MEMORY_SCOPE_WORKGROUP);
    }
    BAR_L();
    if (misc[2] != 0u) {
        diff_core<true>(c, rowbase, h, qb, qlds, l1, l2, o1, o2);
        l1 = swapsum(l1); l2 = swapsum(l2);
    }
    LAS float* wsf = (LAS float*)(c.lds + A_WSF) + c.wid * 64;
    if (c.hi == 0) { wsf[c.r32] = 1.0f / l1; wsf[32 + c.r32] = lam / l2; }
    LDS_WAIT();
    f32x16 od[2]; float one[16];
#pragma unroll
    for (int r = 0; r < 16; ++r) { const int q = crow(r, c.hi); const float a = wsf[q], bb = wsf[32 + q]; od[0][r] = o1[0][r] * a - o2[0][r] * bb; od[1][r] = o1[1][r] * a - o2[1][r] * bb; one[r] = 1.0f; }
    LAS float* stg = (LAS float*)(c.lds + A_OST + c.wid * 8192);
    stage_o(stg, od, one, c.r32, c.hi);
    store_o<true>(stg, c.o + (size_t)(rowbase + qmin) * DM + 256 + h * 64, c.lane, subln, outscale);
}

__device__ __forceinline__ void moba_select_unit(const Ctx& c, int b, int h, int qb, const float* kmsum, unsigned* mcnt, unsigned* mlist) {
    const long rowbase = (long)b * SEQ; const int q0 = qb * 256, qabs = q0 + 32 * c.wid + c.r32, bh = b * 4 + h;
    LAS float* km = (LAS float*)(c.lds + A_KM);
    for (int idx = c.tid; idx < qb * 64; idx += 512) km[idx] = __hip_atomic_load(kmsum + (size_t)(b * 32 + (idx >> 6)) * 256 + h * 64 + (idx & 63), __ATOMIC_RELAXED, __HIP_MEMORY_SCOPE_AGENT);
    __syncthreads();
    float qv[64];
#pragma unroll
    for (int j = 0; j < 8; ++j) { const unsigned long long* qp_ = (const unsigned long long*)(c.proj + (size_t)(rowbase + qabs) * INC + CA_Q + h * 64 + j * 8);
        const unsigned long long lo_ = __hip_atomic_load(qp_, __ATOMIC_RELAXED, __HIP_MEMORY_SCOPE_AGENT), hi_ = __hip_atomic_load(qp_ + 1, __ATOMIC_RELAXED, __HIP_MEMORY_SCOPE_AGENT);
        u32x4 w; w.x = (unsigned)lo_; w.y = (unsigned)(lo_ >> 32); w.z = (unsigned)hi_; w.w = (unsigned)(hi_ >> 32);
        qv[8 * j + 0] = bf_lo(w.x); qv[8 * j + 1] = bf_hi(w.x); qv[8 * j + 2] = bf_lo(w.y); qv[8 * j + 3] = bf_hi(w.y); qv[8 * j + 4] = bf_lo(w.z); qv[8 * j + 5] = bf_hi(w.z); qv[8 * j + 6] = bf_lo(w.w); qv[8 * j + 7] = bf_hi(w.w); }
    float v0 = -INFINITY, v1 = -INFINITY, v2 = -INFINITY; int i0 = 64, i1 = 64, i2 = 64;
#define MOBA_INS(g, n) do { const float g_ = (g); const int n_ = (n); \
    if (g_ > v0 || (g_ == v0 && n_ < i0)) { v2 = v1; i2 = i1; v1 = v0; i1 = i0; v0 = g_; i0 = n_; } \
    else if (g_ > v1 || (g_ == v1 && n_ < i1)) { v2 = v1; i2 = i1; v1 = g_; i1 = n_; } \
    else if (g_ > v2 || (g_ == v2 && n_ < i2)) { v2 = g_; i2 = n_; } } while (0)
    for (int nn = 0; 2 * nn < qb; ++nn) {
        const int n = 2 * nn + c.hi;
        if (n < qb) { float g = 0.f;
#pragma unroll
            for (int d4 = 0; d4 < 16; ++d4) { const f32x4 k4 = *(const LAS f32x4*)(km + n * 64 + 4 * d4); g += (qv[4 * d4] * k4.x + qv[4 * d4 + 1] * k4.y) + (qv[4 * d4 + 2] * k4.z + qv[4 * d4 + 3] * k4.w); }
            MOBA_INS(g, n); }
    }
    const float pv0 = shflx(v0, 32, c.lane), pv1 = shflx(v1, 32, c.lane), pv2 = shflx(v2, 32, c.lane); const int pi0 = shflxi(i0, 32, c.lane), pi1 = shflxi(i1, 32, c.lane), pi2 = shflxi(i2, 32, c.lane);
    if (pi0 < 64) MOBA_INS(pv0, pi0);
    if (pi1 < 64) MOBA_INS(pv1, pi1);
    if (pi2 < 64) MOBA_INS(pv2, pi2);
#undef MOBA_INS
    if (c.hi == 0) {
        const int sel[3] = {i0, i1, i2};
#pragma unroll
        for (int j = 0; j < 3; ++j) if (sel[j] < 64) {
            const unsigned pos = __hip_atomic_fetch_add(mcnt + (size_t)(bh * 32 + sel[j]) * 64, 1u, __ATOMIC_RELAXED, __HIP_MEMORY_SCOPE_AGENT);
            mlist[(size_t)(bh * 32 + sel[j]) * 8192 + pos] = (unsigned)qabs | ((unsigned)j << 16);
        }
    }
}
__device__ __forceinline__ void store_part(const Ctx& c, const LAS float* stg, unsigned entry, float m, float l, int bh, bf16_t* po, float* pml) {
    LAS unsigned* ent = (LAS unsigned*)(c.lds + A_MISC) + 64 + c.wid * 32;
    if (c.hi == 0) { ent[c.r32] = entry;
        if (entry != 0xffffffffu) { f32x2_t v = {m, l}; *(f32x2_t*)(pml + ((size_t)(bh * 8192 + (entry & 0xffffu)) * 4 + (entry >> 16)) * 2) = v; } }
    LDS_WAIT();
    const int ch = c.lane & 7;
#pragma unroll
    for (int i = 0; i < 4; ++i) { const int row = i * 8 + (c.lane >> 3); const unsigned e = ent[row];
        const f32x4 a = *(const LAS f32x4*)(stg + row * 64 + ch * 8), b = *(const LAS f32x4*)(stg + row * 64 + ch * 8 + 4);
        u32x4 w; w.x = cvtpk(a.x, a.y); w.y = cvtpk(a.z, a.w); w.z = cvtpk(b.x, b.y); w.w = cvtpk(b.z, b.w);
        if (e != 0xffffffffu) *(u32x4*)(po + ((size_t)(bh * 8192 + (e & 0xffffu)) * 4 + (e >> 16)) * 64 + ch * 8) = w; }
    LDS_WAIT();
}
struct MUnit { int bh, n, chunk, cnt, sparse; };
__device__ __forceinline__ MUnit moba_desc(int u, int nsp_w, int bid, int G, const LAS int* pre, const LAS int* lcnt) {
    MUnit U;
    if (u < nsp_w) { const int item = bid + u * G; int lo_ = 0, hi_ = 511; while (lo_ < hi_) { const int mid = (lo_ + hi_) >> 1; if (pre[mid] > item) hi_ = mid; else lo_ = mid + 1; }
        const int li = __builtin_amdgcn_readfirstlane(lo_); U.chunk = item - (li > 0 ? __builtin_amdgcn_readfirstlane(pre[li > 0 ? li - 1 : 0]) : 0); U.cnt = __builtin_amdgcn_readfirstlane(lcnt[li]); U.bh = li >> 5; U.n = li & 31; U.sparse = 1; }
    else { const int item = __builtin_amdgcn_readfirstlane(bid + (u - nsp_w) * G); U.n = 31 - (item >> 4); U.bh = item & 15; U.chunk = 0; U.cnt = 256; U.sparse = 0; }
    return U;
}
__device__ __forceinline__ unsigned moba_entry_raw(const Ctx& c, const MUnit& U, const unsigned* mlist) {
    if (U.sparse) { const int ridx = U.chunk * 256 + 32 * c.wid + c.r32; return mlist[(size_t)(U.bh * 32 + U.n) * 8192 + (ridx < U.cnt ? ridx : 0)]; }
    return (unsigned)(U.n * 256 + 32 * c.wid + c.r32) | (3u << 16);
}
__device__ __forceinline__ void moba_stage(const Ctx& c, const MUnit& U) {
    const KVB kvb = kv_base<false>(c, (long)(U.bh >> 2) * SEQ, CA_K + (U.bh & 3) * 64, 0, CA_V + (U.bh & 3) * 64);
#pragma unroll
    for (int j = 0; j < 4; ++j) stage_kvb(c, j, kvb, U.n * 256 + 64 * j);
}
__device__ __forceinline__ void moba_loadq(const Ctx& c, const MUnit& U, unsigned eraw, bf16x8 (&qf)[4]) {
    const int t = (int)(eraw & 0xffffu); const long rowbase = (long)(U.bh >> 2) * SEQ;
#pragma unroll
    for (int d0 = 0; d0 < 4; ++d0) qf[d0] = *(const bf16x8*)(c.proj + (size_t)(rowbase + t) * INC + CA_Q + (U.bh & 3) * 64 + d0 * 16 + c.hi * 8);
}
__device__ __forceinline__ void moba_units(const Ctx& c, int bid, int G, int NSP, const LAS int* pre, const LAS int* lcnt, const unsigned* mlist, bf16_t* po, float* pml) {
    const int nsp_w = (NSP > bid) ? (NSP - bid + G - 1) / G : 0, nown_w = (512 > bid) ? (512 - bid + G - 1) / G : 0, NU = nsp_w + nown_w;
    if (NU == 0) return;
    MUnit U = moba_desc(0, nsp_w, bid, G, pre, lcnt);
    __syncthreads();
    moba_stage(c, U);
    unsigned eraw = moba_entry_raw(c, U, mlist);
    bf16x8 qf[4];
    moba_loadq(c, U, eraw, qf);
#pragma unroll 1
    for (int u = 0; u < NU; ++u) {
        asm volatile("" : "+v"(qf[0]), "+v"(qf[1]), "+v"(qf[2]), "+v"(qf[3]));
        WAIT_BAR(0);
        const bool more = (u + 1 < NU);
        MUnit Un = U; unsigned en = 0u;
        if (more) { Un = moba_desc(u + 1, nsp_w, bid, G, pre, lcnt); en = moba_entry_raw(c, Un, mlist); }
        const int h = U.bh & 3, n = U.n; const bool SPARSE = U.sparse != 0;
        const int ridx = U.chunk * 256 + 32 * c.wid + c.r32; const int t = (int)(eraw & 0xffffu);
        const unsigned entry = (!SPARSE || ridx < U.cnt) ? eraw : 0xffffffffu;
        float m = 0.f, l = 0.f; unsigned qx = 0u; f32x16 o[2]; o[0] = (f32x16){}; o[1] = (f32x16){};
        LAS float* wsf = (LAS float*)(c.lds + A_WSF) + c.wid * 64; const LAS float* tab = (const LAS float*)(c.lds + A_TAB) + h * 128;
        const int wmin = n * 256 + 32 * c.wid;
#define MOBA_TILES(SAFE_) _Pragma("unroll 1") for (int j = 0; j < 4; ++j) { \
        const int k0 = n * 256 + 64 * j; \
        if (!SPARSE && k0 > wmin + 31) break; \
        ldsp cur = c.lds + A_KV + j * 16384; \
        f32x16 p0, p1; bf16x8 pa[4]; \
        qk_tile<4, SAFE_>(p0, p1, cur, qf, c.r32, c.hi, qx); \
        const int dbase = t - k0; \
        const bool causal = !SPARSE && (k0 + 63 > wmin), lookup = __any(dbase - 63 < 113) != 0; \
        if (lookup || causal) mask_bias(p0, p1, dbase, c.hi, tab, lookup, 113, causal, false, false); \
        if (SAFE_) softmax_tile(p0, p1, m, l, o, wsf, c.r32, c.hi, pa, qx); else softmax_fast(p0, p1, l, pa); \
        pv_tile<1>(o, o, cur + 8192, pa, pa, c.lane, c.hi); }
        MOBA_TILES(false)
        if (__any(!acc_in_range(swapsum(l), o))) { m = 0.f; l = 0.f; qx = 0u; o[0] = (f32x16){}; o[1] = (f32x16){}; MOBA_TILES(true) }
#undef MOBA_TILES
        BAR_L();
        if (more) { moba_stage(c, Un); moba_loadq(c, Un, en, qf); }
        l = swapsum(l);
        if (c.hi == 0) wsf[c.r32] = 1.0f / l;
        LDS_WAIT();
        float rs[16];
#pragma unroll
        for (int r = 0; r < 16; ++r) rs[r] = wsf[crow(r, c.hi)];
        LAS float* stg = (LAS float*)(c.lds + A_OST + c.wid * 8192);
        stage_o(stg, o, rs, c.r32, c.hi);
        LDS_WAIT();
        store_part(c, stg, entry, m, l, U.bh, po, pml);
        U = Un; eraw = en;
    }
}
__device__ __forceinline__ void moba_combine(const Frame& F, const bf16_t* po, const float* pml, bf16_t* o) {
    const int gt = F.bid * 512 + F.tid, NT_ = F.G * 512;
    f32x2_t ml1[4]; u32x4 pv1[4];
#define COMB_ISSUE(idx_) do { const int ch_ = (idx_) & 7, hh_ = ((idx_) >> 3) & 3, row_ = (idx_) >> 5, bh_ = (row_ >> 13) * 4 + hh_; const size_t base_ = (size_t)(bh_ * 8192 + (row_ & 8191)) * 4; \
        _Pragma("unroll") for (int j = 0; j < 4; ++j) { ml1[j] = *(const f32x2_t*)(pml + (base_ + j) * 2); pv1[j] = *(const u32x4*)(po + (base_ + j) * 64 + ch_ * 8); } } while (0)
    if (gt < NTOK * 32) COMB_ISSUE(gt);
    for (int idx = gt; idx < NTOK * 32; idx += NT_) {
        const int ch = idx & 7, hh = (idx >> 3) & 3, row = idx >> 5, t = row & 8191, nsel = (t >> 8) < 3 ? (t >> 8) : 3;
        f32x2_t ml[4]; u32x4 pv[4];
#pragma unroll
        for (int j = 0; j < 4; ++j) { ml[j] = ml1[j]; pv[j] = pv1[j]; }
        if (idx + NT_ < NTOK * 32) COMB_ISSUE(idx + NT_);
        float M = -INFINITY;
#pragma unroll
        for (int j = 0; j < 4; ++j) { const bool on = (j == 3) || (j < nsel); M = on ? fmaxf(M, ml[j].x) : M; }
        float acc[8] = {0.f, 0.f, 0.f, 0.f, 0.f, 0.f, 0.f, 0.f}; float ws = 0.f;
#pragma unroll
        for (int j = 0; j < 4; ++j) { const bool on = (j == 3) || (j < nsel);
            const float w = on ? ml[j].y * __builtin_amdgcn_exp2f(ml[j].x - M) : 0.f; ws += w;
            u32x4 v = pv[j]; if (!on) v = (u32x4){0u, 0u, 0u, 0u};
            acc[0] += w * bf_lo(v.x); acc[1] += w * bf_hi(v.x); acc[2] += w * bf_lo(v.y); acc[3] += w * bf_hi(v.y); acc[4] += w * bf_lo(v.z); acc[5] += w * bf_hi(v.z); acc[6] += w * bf_lo(v.w); acc[7] += w * bf_hi(v.w); }
        const float inv = 1.0f / ws;
        u32x4 w; w.x = cvtpk(acc[0] * inv, acc[1] * inv); w.y = cvtpk(acc[2] * inv, acc[3] * inv); w.z = cvtpk(acc[4] * inv, acc[5] * inv); w.w = cvtpk(acc[6] * inv, acc[7] * inv);
        *(u32x4*)(o + (size_t)row * DM + hh * 64 + ch * 8) = w;
    }
#undef COMB_ISSUE
}

template <bool SAFE, bool PRE = false>
__device__ __forceinline__ void swa_core(const Ctx& c, long rowbase, int hq, int qb, float sink, const bf16x8 (&qf)[4], float& m, float& l, f32x16 (&o)[2]) {
    const int q0 = qb * 256, qmin = q0 + 32 * c.wid, qabs = qmin + c.r32, kvh = hq >> 1;
    unsigned qx = 0u;
    if (SAFE) { m = bf_round(sink * LOG2E); l = (c.hi == 0) ? __builtin_amdgcn_exp2f(sink * LOG2E - m) : 0.0f; qx = qx_frag(m, c.hi); }
    else { m = 0.f; l = (c.hi == 0) ? __builtin_amdgcn_exp2f(sink * LOG2E) : 0.0f; }
    o[0] = (f32x16){}; o[1] = (f32x16){};
    LAS float* wsf = (LAS float*)(c.lds + A_WSF) + c.wid * 64; const LAS float* tab = (const LAS float*)(c.lds + A_TAB) + (8 + hq) * 128;
    const int kstart = q0 >= 128 ? q0 - 128 : 0, NT = (q0 + 256 - kstart) / 64;
    const KVB kvb = kv_base<false>(c, rowbase, CD_K + kvh * 64, 0, CD_V + kvh * 64);
    if (!PRE) { VM_WAIT(); stage_kvb(c, 0, kvb, kstart); stage_kvb(c, 1, kvb, kstart + 64); }
    WAIT_BAR(2);
    int sl = 0;
    for (int t = 0; t < NT; ++t) {
        ldsp cur = c.lds + A_KV + sl * 16384;
        if (t + 2 < NT) stage_kvb(c, sl >= 1 ? sl - 1 : 2, kvb, kstart + 64 * (t + 2));
        const int k0 = kstart + 64 * t;
        if (k0 <= qmin + 31 && k0 + 63 >= qmin - 127) {
            f32x16 p0, p1; bf16x8 pa[4];
            qk_tile<4, SAFE>(p0, p1, cur, qf, c.r32, c.hi, qx);
            mask_bias(p0, p1, qabs - k0, c.hi, tab, true, 127, true, true, false);
            if (SAFE) softmax_tile(p0, p1, m, l, o, wsf, c.r32, c.hi, pa, qx); else softmax_fast(p0, p1, l, pa);
            pv_tile<1>(o, o, cur + 8192, pa, pa, c.lane, c.hi);
        }
        if (t + 2 < NT) WAIT_BAR(2); else WAIT_BAR(0);
        sl = sl == 2 ? 0 : sl + 1;
    }
}
__device__ __forceinline__ void swa_unit(const Ctx& c, int b, int hq, int qb, float sink) {
    const long rowbase = (long)b * SEQ; const int q0 = qb * 256, qmin = q0 + 32 * c.wid, qabs = qmin + c.r32;
    LAS unsigned* misc = (LAS unsigned*)(c.lds + A_MISC);
    if (c.tid == 0) misc[2] = 0u;
    { const int kvh = hq >> 1, kstart = q0 >= 128 ? q0 - 128 : 0; const KVB kvb0 = kv_base<false>(c, rowbase, CD_K + kvh * 64, 0, CD_V + kvh * 64);
      stage_kvb(c, 0, kvb0, kstart); stage_kvb(c, 1, kvb0, kstart + 64); }
    bf16x8 qf[4];
#pragma unroll
    for (int d0 = 0; d0 < 4; ++d0) qf[d0] = *(const bf16x8*)(c.proj + (size_t)(rowbase + qabs) * INC + CD_Q + hq * 64 + d0 * 16 + c.hi * 8);
    asm volatile("" : "+v"(qf[0]), "+v"(qf[1]), "+v"(qf[2]), "+v"(qf[3]));
    float m, l; f32x16 o[2];
    swa_core<false, true>(c, rowbase, hq, qb, sink, qf, m, l, o);
    l = swapsum(l);
    if (__any(!acc_in_range(l, o)) && c.lane == 0) __hip_atomic_fetch_or(misc + 2, 1u, __ATOMIC_RELAXED, __HIP_MEMORY_SCOPE_WORKGROUP);
    BAR_L();
    if (misc[2] != 0u) { swa_core<true>(c, rowbase, hq, qb, sink, qf, m, l, o); l = swapsum(l); }
    LAS float* wsf = (LAS float*)(c.lds + A_WSF) + c.wid * 64;
    if (c.hi == 0) wsf[c.r32] = 1.0f / l;
    LDS_WAIT();
    float rs[16];
#pragma unroll
    for (int r = 0; r < 16; ++r) rs[r] = wsf[crow(r, c.hi)];
    LAS float* stg = (LAS float*)(c.lds + A_OST + c.wid * 8192);
    stage_o(stg, o, rs, c.r32, c.hi);
    store_o<false>(stg, c.o + (size_t)(rowbase + qmin) * DM + 768 + hq * 64, c.lane, nullptr, 1.0f);
}

__device__ __forceinline__ void sb_unit(const Ctx& c, int b, int h, int qb) {
    const long rowbase = (long)b * SEQ; const int q0 = qb * 256, qmin = q0 + 32 * c.wid, qabs = qmin + c.r32;
    LAS unsigned* misc = (LAS unsigned*)(c.lds + A_MISC);
    if (c.tid < 4) misc[16 + c.tid] = 0u;
    const int T0 = 4 * qb + 3;
    const KVB kvb = kv_base<false>(c, rowbase, CC_K + h * 64, 0, CC_V + h * 64);
    stage_kvb(c, 0, kvb, 64 * T0);
    stage_kvb(c, 1, kvb, 64 * (T0 - 1));
    bf16x8 qf[4];
#pragma unroll
    for (int d0 = 0; d0 < 4; ++d0) qf[d0] = *(const bf16x8*)(c.proj + (size_t)(rowbase + qabs) * INC + CC_Q + h * 64 + d0 * 16 + c.hi * 8);
    asm volatile("" : "+v"(qf[0]), "+v"(qf[1]), "+v"(qf[2]), "+v"(qf[3]));
    float C = 0.f; f32x16 o[2]; o[0] = (f32x16){}; o[1] = (f32x16){};
    bool wdone = false;
    WAIT_BAR(2);
    int sl = 0;
    for (int i = 0, t = T0; t >= 0; --t, ++i) {
        ldsp cur = c.lds + A_KV + sl * 16384;
        if (t > 1) stage_kvb(c, sl >= 1 ? sl - 1 : 2, kvb, 64 * (t - 2));
        if (c.tid == 0) misc[16 + ((i + 2) & 3)] = 0u;
        const int k0 = 64 * t;
        if (!wdone && k0 <= qmin + 31) {
            f32x16 y0, y1;
            qk_tile<4, false>(y0, y1, cur, qf, c.r32, c.hi);
            const int dbase = qabs - k0;
            f32x16 L0, L1;
#pragma unroll
            for (int r = 0; r < 16; ++r) {
                const int d0 = dbase - crow(r, c.hi), d1 = d0 - 32;
                { const float y = y0[r], a = __builtin_amdgcn_logf(1.0f + __builtin_amdgcn_exp2f(-fabsf(y))); L0[r] = d0 > 0 ? -(fmaxf(y, 0.f) + a) : 0.f; y0[r] = fminf(y, 0.f) - a; }
                { const float y = y1[r], a = __builtin_amdgcn_logf(1.0f + __builtin_amdgcn_exp2f(-fabsf(y))); L1[r] = d1 > 0 ? -(fmaxf(y, 0.f) + a) : 0.f; y1[r] = fminf(y, 0.f) - a; }
            }
            float Te[2][4], To[2][4];
#pragma unroll
            for (int k = 0; k < 4; ++k) {
                { const float a0 = L0[4 * k], a1 = L0[4 * k + 1], a2 = L0[4 * k + 2], a3 = L0[4 * k + 3]; const float s2 = a3, s1 = a3 + a2, s0 = s1 + a1, T = s0 + a0;
                  L0[4 * k] = s0; L0[4 * k + 1] = s1; L0[4 * k + 2] = s2; L0[4 * k + 3] = 0.f;
                  auto rr = __builtin_amdgcn_permlane32_swap(__float_as_uint(T), __float_as_uint(T), false, false); Te[0][k] = __uint_as_float(rr[0]); To[0][k] = __uint_as_float(rr[1]); }
                { const float a0 = L1[4 * k], a1 = L1[4 * k + 1], a2 = L1[4 * k + 2], a3 = L1[4 * k + 3]; const float s2 = a3, s1 = a3 + a2, s0 = s1 + a1, T = s0 + a0;
                  L1[4 * k] = s0; L1[4 * k + 1] = s1; L1[4 * k + 2] = s2; L1[4 * k + 3] = 0.f;
                  auto rr = __builtin_amdgcn_permlane32_swap(__float_as_uint(T), __float_as_uint(T), false, false); Te[1][k] = __uint_as_float(rr[0]); To[1][k] = __uint_as_float(rr[1]); }
            }
            float run = 0.f, Bown[2][4];
#pragma unroll
            for (int ph = 1; ph >= 0; --ph)
#pragma unroll
                for (int k = 3; k >= 0; --k) { const float Bo = run; run += To[ph][k]; const float Be = run; run += Te[ph][k]; Bown[ph][k] = c.hi ? Bo : Be; }
#pragma unroll
            for (int r = 0; r < 16; ++r) {
                const int d0 = dbase - crow(r, c.hi), d1 = d0 - 32;
                y0[r] = d0 > 0 ? __builtin_amdgcn_exp2f(y0[r] + (C + Bown[0][r >> 2] + L0[r])) : 0.f;
                y1[r] = d1 > 0 ? __builtin_amdgcn_exp2f(y1[r] + (C + Bown[1][r >> 2] + L1[r])) : 0.f;
            }
            C += run;
            bf16x8 pa[4];
            pack_p(y0, y1, pa);
            pv_tile<1>(o, o, cur + 8192, pa, pa, c.lane, c.hi);
            if (__all(C < -150.0f)) wdone = true;
        }
        if ((wdone || t == 0) && c.lane == 0) __hip_atomic_fetch_add(misc + 16 + (i & 3), 1u, __ATOMIC_RELAXED, __HIP_MEMORY_SCOPE_WORKGROUP);
        if (t > 1) WAIT_BAR(2); else WAIT_BAR(0);
        sl = sl == 2 ? 0 : sl + 1;
        if (misc[16 + (i & 3)] == 8u) break;
    }
    float one[16];
#pragma unroll
    for (int r = 0; r < 16; ++r) one[r] = 1.0f;
    LAS float* stg = (LAS float*)(c.lds + A_OST + c.wid * 8192);
    stage_o(stg, o, one, c.r32, c.hi);
    store_o<false>(stg, c.o + (size_t)(rowbase + qmin) * DM + 512 + h * 64, c.lane, nullptr, 1.0f);
}

__device__ __forceinline__ Ctx make_ctx(const Frame& F) {
    Ctx c; c.lds = F.lds; c.proj = (const bf16_t*)(F.ws + WS_PROJ); c.o = (bf16_t*)(F.ws + WS_O); c.tid = F.tid; c.lane = F.lane; c.wid = F.wave; c.r32 = F.lane & 31; c.hi = F.lane >> 5; c.shadow = 0; return c;
}
#define ATT_FRESH() { int ln_ = F.lane; asm volatile("" : "+v"(ln_)); c.lane = ln_; c.tid = F.wave * 64 + ln_; c.r32 = ln_ & 31; c.hi = ln_ >> 5; }
#define ATT_QUEUE(k, NITEMS, ...) for (;;) { __syncthreads(); if (F.tid == 0) misc[0] = __hip_atomic_fetch_add(qh + (k) * 64, 1u, __ATOMIC_RELAXED, __HIP_MEMORY_SCOPE_AGENT); __syncthreads(); \
        const int item = (int)misc[0]; if (item >= (NITEMS)) break; ATT_FRESH(); __VA_ARGS__; }
#define ATT_STATIC(NITEMS, ...) for (int item = F.bid; item < (NITEMS); item += F.G) { __syncthreads(); ATT_FRESH(); __VA_ARGS__; }
__device__ __forceinline__ void ph_attn_select(const Frame& F, int l) {
    const int nl = F.G, me = F.bid;
    Ctx c = make_ctx(F);
    LAS unsigned* misc = (LAS unsigned*)(F.lds + A_MISC);
    const float* kmsum = (const float*)((const unsigned char*)F.ctl + CTL_KMEAN) + (size_t)l * 128 * 256;
    unsigned* mcnt = (unsigned*)((unsigned char*)F.ctl + CTL_MCNT) + (size_t)l * 512 * 64; unsigned* mlist = (unsigned*)(F.ws + WS_MLIST);
    __syncthreads();
    if (F.tid == 0) { unsigned sp = 0u; while (__hip_atomic_load(F.ctl + CW_KDONE + l * 64, __ATOMIC_RELAXED, __HIP_MEMORY_SCOPE_AGENT) < (unsigned)((NTOK / 256) * 8 * 2)) {     __builtin_amdgcn_s_sleep(2); if (++sp > (1u << 26)) break; } }
    __syncthreads();
    for (int item = me; item < 496; item += nl) { __syncthreads(); ATT_FRESH(); const int qb = 31 - (item >> 4), b = (item >> 2) & 3, h = item & 3; moba_select_unit(c, b, h, qb, kmsum, mcnt, mlist); }
}
__device__ __forceinline__ void ph_attn(const Frame& F, int l, int rep = 0, int amask = 15) {
    Ctx c = make_ctx(F); c.shadow = rep;
    LAS unsigned* misc = (LAS unsigned*)(F.lds + A_MISC);
    build_tables(c, F.in[1]);
    const float lam = __uint_as_float(__hip_atomic_load(F.ctl + CW_LAM + l, __ATOMIC_RELAXED, __HIP_MEMORY_SCOPE_AGENT));
    unsigned* mcnt = (unsigned*)((unsigned char*)F.ctl + CTL_MCNT) + (size_t)l * 512 * 64; const unsigned* mlist = (const unsigned*)(F.ws + WS_MLIST);
    bf16_t* po = (bf16_t*)(F.ws + WS_MPO); float* pml = (float*)(F.ws + WS_MML);
    unsigned* qh = F.ctl + CW_Q + l * 8 * 64 + rep * 2048;
    LAS int* pre = (LAS int*)(F.lds + A_MISC) + 320;
    LAS int* lcnt = (LAS int*)(F.lds + A_MISC) + 832;
    { const int cn = (int)__hip_atomic_load(mcnt + (size_t)F.tid * 64, __ATOMIC_RELAXED, __HIP_MEMORY_SCOPE_AGENT); pre[F.tid] = (cn + 255) >> 8; lcnt[F.tid] = cn; }
    __syncthreads();
    for (int d = 1; d < 512; d <<= 1) { const int v = (F.tid >= d) ? pre[F.tid - d] : 0; __syncthreads(); pre[F.tid] += v; __syncthreads(); }
    const int NSP = pre[511];
#ifndef AMASK
#define AMASK 15
#endif
    if (amask & AMASK & 1) ATT_QUEUE(0, 512, { const int qb = 31 - (item >> 4), b = (item >> 2) & 3, h = item & 3; diff_unit(c, b, h, qb, lam, F.in[8] + l * 64, 1.0f - lam_init_of(l)); })
    if (amask & AMASK & 2) {
        { ATT_FRESH(); moba_units(c, F.bid, F.G, NSP, pre, lcnt, mlist, po, pml); }
    }
    if (amask & AMASK & 4) ATT_STATIC(512, { const int qb = 31 - (item >> 4), b = (item >> 2) & 3, h = item & 3; swa_unit(c, b, h, qb, F.in[9][l * 4 + h]); })
    if (amask & AMASK & 8) ATT_STATIC(512, { const int qb = 31 - (item >> 4), b = (item >> 2) & 3, h = item & 3; sb_unit(c, b, h, qb); })
}
#undef ATT_QUEUE
#undef ATT_STATIC
#undef ATT_FRESH
}

constexpr int NPL = 8, NPH = 1 + NPL * DEPTH;
struct Persist { int wave0, lo, hi; };
__device__ __forceinline__ void refresh(Frame& F, const Persist& P) {
    const unsigned char __attribute__((address_space(4)))* kp = (const unsigned char __attribute__((address_space(4)))*)__builtin_amdgcn_kernarg_segment_ptr();
    asm volatile("" : "+s"(kp));
    F.in = (karg_in_t)kp;
    F.out = *(float* __attribute__((address_space(4)))*)(kp + 176);
    F.ws = *(unsigned char* __attribute__((address_space(4)))*)(kp + 184);
    F.ctl = (unsigned*)(F.ws + WS_CTL);
    int w = P.wave0; asm volatile("" : "+s"(w));
    unsigned ones = ~0u; asm volatile("" : "+s"(ones));
    int ln = (int)__builtin_amdgcn_mbcnt_hi(ones, __builtin_amdgcn_mbcnt_lo(ones, 0u)); asm volatile("" : "+v"(ln));
    F.wave = w; F.lane = ln; F.tid = w * 64 + ln;
    int g = (int)gridDim.x, b = (int)blockIdx.x; asm volatile("" : "+s"(g), "+s"(b));
    F.G = g; F.bid = b;
    unsigned l0 = 0; asm volatile("" : "+s"(l0));
    F.lds = (ldsp)(uintptr_t)l0;
}
#ifndef KMASK
#define KMASK 0xffff
#endif
#define KON(j) ((KMASK >> (j)) & 1)
#define FULLBAR() do { refresh(F, P); XcdBarrier b_; b_.bar = F.ctl + CW_BAR; b_.x = barx; b_.st = (volatile LAS unsigned*)(F.lds + LDS_XB); xcd_barrier(b_, F.tid == 0); } while (0)
#define IN(k) (lo <= (k) && (k) < hi)
#define SEAM(k) do { if (IN(k) && IN((k) + 1)) { refresh(F, P); XcdBarrier b_; b_.bar = F.ctl + CW_BAR; b_.x = barx; b_.st = (volatile LAS unsigned*)(F.lds + LDS_XB); xcd_barrier(b_, F.tid == 0); } } while (0)

template <int l>
__device__ __forceinline__ void run_layer(Frame& F, const Persist& P, const int lo, const int hi, const unsigned barx) {
        const int pb = 1 + NPL * l;
        if (KON(0) && IN(pb + 0)) {
            refresh(F, P);
            SchedProj S{(const char*)(F.ws + WS_H), (const char*)(F.ws + WS_WIN), F.G, F.bid};
            EpiBf16 E{(bf16_t*)(F.ws + WS_PROJ), INC, (float*)((unsigned char*)F.ctl + CTL_KMEAN) + (size_t)l * 128 * 256, F.ctl + CW_KDONE + l * 64};
            pg8::gemm_stream(F.lds, F.tid, S, E);
            refresh(F, P); att::ph_attn_select(F, l);
        }
        SEAM(pb + 0);
        if (KON(2) && IN(pb + 1)) { refresh(F, P); att::ph_attn(F, l); }
#ifdef PROBE_REP_ATT
        if (IN(pb + 1)) { refresh(F, P); XcdBarrier b_; b_.bar = F.ctl + CW_BAR; b_.x = barx; b_.st = (volatile LAS unsigned*)(F.lds + LDS_XB); xcd_barrier(b_, F.tid == 0); refresh(F, P); att::ph_attn(F, l, 1, PROBE_REP_ATT); }
#endif
        SEAM(pb + 1);
        if (KON(3) && IN(pb + 2)) { refresh(F, P); att::moba_combine(F, (const bf16_t*)(F.ws + WS_MPO), (const float*)(F.ws + WS_MML), (bf16_t*)(F.ws + WS_O)); }
        SEAM(pb + 2);
        if (KON(4) && IN(pb + 3)) {
            refresh(F, P);
            SchedGate S{(const char*)(F.ws + WS_H8), (const char*)(F.ws + WS_O), (const char*)(F.ws + WS_WG), (const char*)(F.ws + WS_WBR), F.G, F.bid};
            EpiGate E{(bf16_t*)(F.ws + WS_MERGED), F.ws + WS_S + (size_t)F.bid * 131072};
            pg8::gemm_stream<EpiGate, SchedGate, 2>(F.lds, F.tid, S, E);
        }
        SEAM(pb + 3);
        if (KON(5) && IN(pb + 4)) {
            refresh(F, P);
            SchedWo S{(const char*)(F.ws + WS_MERGED), (const char*)(F.ws + WS_WO), F.G, F.bid};
            EpiResid<l == 0> E{F.in[0], (const bf16_t*)(F.ws + WS_R), (bf16_t*)(F.ws + WS_R)};
            pg8::gemm_stream(F.lds, F.tid, S, E);
        }
        SEAM(pb + 4);
        if (KON(6) && IN(pb + 5)) { refresh(F, P); ph_route(F, l, (const bf16_t*)(F.ws + WS_R), F.ws + WS_H2, (unsigned*)(F.ws + WS_TOK), (unsigned*)(F.ws + WS_ELIST)); }
        SEAM(pb + 5);
        if (KON(8) && IN(pb + 6)) {
            refresh(F, P); moe_tables(F, l);
            SchedMoe<1024u, 1024u, 8, true> S{F.lds, (const char*)(F.ws + WS_H2), (const char*)(F.ws + WS_W13), F.G, F.bid, (const unsigned*)(F.ws + WS_ELIST), F.ctl + CW_HDONE + l * 512};
            EpiSilu E{F.ws + WS_HID, 1.0f / 32.0f, F.ctl + CW_HDONE + l * 512};
            pg8::gemm_stream<EpiSilu, SchedMoe<1024u, 1024u, 8, true>, 1>(F.lds, F.tid, S, E);
        }
        if (KON(9) && IN(pb + 6)) {
            refresh(F, P);
            SchedMoe<512u, 512u, 4, false> S{F.lds, (const char*)(F.ws + WS_HID), (const char*)(F.ws + WS_W2), F.G, F.bid, nullptr, F.ctl + CW_HDONE + l * 512};
            EpiFp8 E{F.ws + WS_Y8, DM, 8.0f / 16.0f};
            pg8::gemm_stream<EpiFp8, SchedMoe<512u, 512u, 4, false>, 1>(F.lds, F.tid, S, E);
        }
        SEAM(pb + 6);
        if (KON(10) && IN(pb + 7)) {
            refresh(F, P);
            if (l + 1 < DEPTH) { ph_convert(F, l + 1); ph_combine(F, l, (const bf16_t*)(F.ws + WS_R), F.ws + WS_Y8, (const unsigned*)(F.ws + WS_TOK), F.in[2] + (size_t)(l + 1) * DM, F.out, (bf16_t*)(F.ws + WS_R), (bf16_t*)(F.ws + WS_H), F.ws + WS_H8, false); }
            else ph_combine(F, l, (const bf16_t*)(F.ws + WS_R), F.ws + WS_Y8, (const unsigned*)(F.ws + WS_TOK), F.in[21], F.out, (bf16_t*)(F.ws + WS_R), (bf16_t*)(F.ws + WS_H), F.ws + WS_H8, true);
        }
        SEAM(pb + 7);
    }
__global__ void __launch_bounds__(512, 2) mk_fwd(Args args_unused) {
    extern __shared__ __attribute__((aligned(16))) unsigned char lds_raw[];
    Frame F; Persist P;
    P.wave0 = __builtin_amdgcn_readfirstlane((int)threadIdx.x >> 6);
    { const unsigned char __attribute__((address_space(4)))* kp = (const unsigned char __attribute__((address_space(4)))*)__builtin_amdgcn_kernarg_segment_ptr();
      P.lo = *(const int __attribute__((address_space(4)))*)(kp + 192); P.hi = *(const int __attribute__((address_space(4)))*)(kp + 196); }
    const int lo = P.lo, hi = P.hi;
    const bool fused = (hi - lo) > 1;
    refresh(F, P);
    if ((ldsp)lds_raw != F.lds) __builtin_trap();
    if (F.tid < 4) ((LAS unsigned*)(F.lds + LDS_XB))[F.tid] = 0u;
    __syncthreads();
    XcdBarrier bar; bar.bar = F.ctl + CW_BAR; bar.x = 0; bar.st = (volatile LAS unsigned*)(F.lds + LDS_XB);
    if (fused) bar = xcd_barrier_post(F.ctl + CW_BAR, (volatile LAS unsigned*)(F.lds + LDS_XB), F.tid == 0);
    const unsigned barx = bar.x;
    if (KON(15) && IN(0)) { refresh(F, P); ph_convert(F, 0); ph_norm(F, F.in[0], F.in[2], (bf16_t*)(F.ws + WS_H), F.ws + WS_H8); ph_lam(F); }
    SEAM(0);
    run_layer<0>(F, P, lo, hi, barx);
    run_layer<1>(F, P, lo, hi, barx);
#undef IN
#undef SEAM
}

extern "C" void kernel_launch(void* const* d_in, const int* in_sizes, int n_in, void* d_out, int out_size, void* d_ws, size_t ws_size, hipStream_t stream) {
    static int grid = 0;
    if (grid == 0) {
        if (n_in != 22 || in_sizes[0] != NTOK * DM || out_size != NTOK * DM || ws_size < WS_END) { fprintf(stderr, "kernel_launch: unexpected shapes (n_in %d, in0 %d, out %d, ws %zu < %zu)\n", n_in, n_in > 0 ? in_sizes[0] : -1, out_size, ws_size, (size_t)WS_END); grid = -1; return; }
        int dev = 0, cus = 0, per_cu = 0;
        if (hipGetDevice(&dev) != hipSuccess || hipDeviceGetAttribute(&cus, hipDeviceAttributeMultiprocessorCount, dev) != hipSuccess) { grid = -1; return; }
        if (hipFuncSetAttribute((const void*)mk_fwd, hipFuncAttributeMaxDynamicSharedMemorySize, LDS_BYTES) != hipSuccess) { fprintf(stderr, "kernel_launch: hipFuncSetAttribute failed\n"); grid = -1; return; }
        if (hipOccupancyMaxActiveBlocksPerMultiprocessor(&per_cu, (const void*)mk_fwd, 512, LDS_BYTES) != hipSuccess || per_cu < 1) fprintf(stderr, "kernel_launch: occupancy query reports %d\n", per_cu);
        (void)hipGetLastError();
        grid = cus;
    }
    if (grid < 0) return;
    if (hipMemsetAsync((char*)d_ws + WS_CTL, 0, CTL_ZERO_BYTES, stream) != hipSuccess) return;
    Args a{};
    for (int i = 0; i < 22; ++i) a.in[i] = (const float*)d_in[i];
    a.out = (float*)d_out; a.ws = (unsigned char*)d_ws;
#if MK_N_LAUNCHES == 1
    a.ph_lo = 0; a.ph_hi = NPH;
    hipLaunchKernelGGL(mk_fwd, dim3(grid), dim3(512), LDS_BYTES, stream, a);
#else
    for (int p = 0; p < NPH; ++p) { a.ph_lo = p; a.ph_hi = p + 1; hipLaunchKernelGGL(mk_fwd, dim3(grid), dim3(512), LDS_BYTES, stream, a); }
#endif
    const hipError_t le = hipPeekAtLastError();
    if (le != hipSuccess) fprintf(stderr, "kernel_launch: launch failed: %s\n", hipGetErrorName(le));
}
```
